# Optimizing an MI355X kernel written in HIP

```python
import jax
import jax.numpy as jnp
from jax import lax
import numpy as np

D_MODEL = 1024
BATCH = 8
SEQ = 4096
DEPTH = 2

N_MIXERS = 2
N_A_LAYERS = (DEPTH + 1) // 2
N_B_LAYERS = DEPTH // 2
RMS_EPS = 1e-6
DILATION_PATTERNS = ((128, 1), (512, 4), (2048, 16))
N_GROUPS_A = 3
HEADS_A = 16
HEAD_DIM_A = D_MODEL // HEADS_A
WIDTH_A = HEADS_A * HEAD_DIM_A
BAND_BLOCK = 128
ROPE_THETA = 10000.0
MAX_POS_OFFSET = 1024
NEG_INF = -1e30
HEADS_B = 4
KEY_DIM_B = D_MODEL // 2 // HEADS_B
VAL_DIM_B = D_MODEL // HEADS_B
HK_B = HEADS_B * KEY_DIM_B
HV_B = HEADS_B * VAL_DIM_B
GATE_RANK = 16
GATE_TAU = 16.0
GLA_CHUNK = 64
B_IN_WIDTH = 2 * HK_B + 2 * HV_B + GATE_RANK
N_EXPERTS = 32
TOP_K = 4
D_FF = D_MODEL
SWIGLU_LIMIT = 7.0
SWIGLU_ALPHA = 1.702
EXPERT_BLOCK = 128

kernel_name = 'hybrid_dilated_gla_moe_adaln'


def rmsnorm(t, gain):
    tf = t.astype(jnp.float32)
    y = tf * lax.rsqrt(jnp.mean(tf * tf, axis=-1, keepdims=True) + RMS_EPS)
    return (y * gain.astype(jnp.float32)).astype(t.dtype)


def rope(t, positions):
    half = t.shape[-1] // 2
    inv_freq = ROPE_THETA ** (-jnp.arange(half, dtype=jnp.float32) / half)
    ang = positions.astype(jnp.float32)[..., None] * inv_freq
    cos = jnp.cos(ang)[:, :, None, :]
    sin = jnp.sin(ang)[:, :, None, :]
    tf = t.astype(jnp.float32)
    t1, t2 = tf[..., :half], tf[..., half:]
    return jnp.concatenate([t1 * cos - t2 * sin, t2 * cos + t1 * sin], axis=-1).astype(t.dtype)


def dilated_window_attention(q, k, v, steps, dil):
    B, S, H, E = q.shape
    L = S // dil
    nb = -(-L // BAND_BLOCK)
    Lp = nb * BAND_BLOCK

    def residue_blocks(a):
        a = a.reshape(B, L, dil, H, E).transpose(0, 2, 1, 3, 4)
        a = jnp.pad(a, ((0, 0), (0, 0), (0, Lp - L), (0, 0), (0, 0)))
        return a.reshape(B, dil, nb, BAND_BLOCK, H, E)

    def with_prev(a):
        prev = jnp.pad(a[:, :, :-1], ((0, 0), (0, 0), (1, 0), (0, 0), (0, 0), (0, 0)))
        return jnp.concatenate([prev, a], axis=3)

    qb = residue_blocks(q)
    kk = with_prev(residue_blocks(k))
    vv = with_prev(residue_blocks(v))
    s = jnp.einsum('brnqhe,brnkhe->brnhqk', qb, kk,
                   preferred_element_type=jnp.float32) * (E ** -0.5)
    qi = jnp.arange(BAND_BLOCK)[:, None]
    kj = jnp.arange(2 * BAND_BLOCK)[None, :]
    delta = qi + BAND_BLOCK - kj
    blk = jnp.arange(nb)[:, None, None]
    valid = (delta >= 0) & (delta <= steps) & ((blk > 0) | (kj >= BAND_BLOCK))
    s = jnp.where(valid[:, None], s, NEG_INF)
    m = jnp.max(s, axis=-1, keepdims=True)
    p = jnp.exp(s - m)
    den = jnp.sum(p, axis=-1, keepdims=True)
    o = jnp.einsum('brnhqk,brnkhe->brnhqe', p, vv.astype(jnp.float32)) / den
    lse = (m + jnp.log(den))[..., 0]
    o = o.transpose(0, 1, 2, 4, 3, 5).reshape(B, dil, Lp, H, E)[:, :, :L]
    o = o.transpose(0, 2, 1, 3, 4).reshape(B, S, H, E)
    lse = lse.transpose(0, 1, 2, 4, 3).reshape(B, dil, Lp, H)[:, :, :L]
    lse = lse.transpose(0, 2, 1, 3).reshape(B, S, H)
    return o, lse


def dilated_mixer(h, positions, w_in, q_gain, k_gain, w_out):
    B, S, _ = h.shape
    qkv = (h @ w_in).reshape(B, S, N_GROUPS_A, 3, HEADS_A, HEAD_DIM_A)
    outs, lses = [], []
    for g, (window, dil) in enumerate(DILATION_PATTERNS):
        q = rope(rmsnorm(qkv[:, :, g, 0], q_gain[g]), positions)
        k = rope(rmsnorm(qkv[:, :, g, 1], k_gain[g]), positions)
        o, lse = dilated_window_attention(q, k, qkv[:, :, g, 2], window // dil, dil)
        outs.append(o)
        lses.append(lse)
    w = jax.nn.softmax(jnp.stack(lses, axis=0), axis=0)
    o = jnp.sum(w[..., None] * jnp.stack(outs, axis=0), axis=0)
    return o.astype(h.dtype).reshape(B, S, WIDTH_A) @ w_out


def gla_mixer(h, w_in, w_gate_up, gate_bias, out_gain, w_out):
    B, S, _ = h.shape
    nc = S // GLA_CHUNK
    proj = h @ w_in
    q, k, v, r, a = jnp.split(proj, [HK_B, 2 * HK_B, 2 * HK_B + HV_B, 2 * HK_B + 2 * HV_B], axis=-1)
    log_alpha = jax.nn.log_sigmoid((a @ w_gate_up + gate_bias).astype(jnp.float32)) / GATE_TAU

    def chunks(t, dim):
        return t.astype(jnp.float32).reshape(B, nc, GLA_CHUNK, HEADS_B, dim).transpose(0, 3, 1, 2, 4)

    q = chunks(q, KEY_DIM_B) * (KEY_DIM_B ** -0.5)
    k = chunks(k, KEY_DIM_B)
    v = chunks(v, VAL_DIM_B)
    b = jnp.cumsum(chunks(log_alpha, KEY_DIM_B), axis=3)
    b_last = b[:, :, :, -1:]
    q_dec = q * jnp.exp(b)
    att = jnp.einsum('bhncd,bhnjd->bhncj', q_dec, k * jnp.exp(-b))
    causal = jnp.tril(jnp.ones((GLA_CHUNK, GLA_CHUNK), dtype=bool))
    att = jnp.where(causal, att, 0.0)
    o_intra = jnp.einsum('bhncj,bhnjv->bhncv', att, v)
    k_dec = k * jnp.exp(b_last - b)
    chunk_decay = jnp.exp(b_last[:, :, :, 0])

    def step(state, inp):
        qd, kd, vc, dec = inp
        o = jnp.einsum('bhcd,bhdv->bhcv', qd, state)
        state = dec[..., None] * state + jnp.einsum('bhcd,bhcv->bhdv', kd, vc)
        return state, o

    xs = (jnp.moveaxis(q_dec, 2, 0), jnp.moveaxis(k_dec, 2, 0),
          jnp.moveaxis(v, 2, 0), jnp.moveaxis(chunk_decay, 2, 0))
    state0 = jnp.zeros((B, HEADS_B, KEY_DIM_B, VAL_DIM_B), jnp.float32)
    _, o_inter = lax.scan(step, state0, xs)
    o = o_intra + jnp.moveaxis(o_inter, 0, 2)
    o = o.transpose(0, 2, 3, 1, 4).reshape(B, S, HEADS_B, VAL_DIM_B)
    o = o * lax.rsqrt(jnp.mean(o * o, axis=-1, keepdims=True) + RMS_EPS) * out_gain.astype(jnp.float32)
    o = o.reshape(B, S, HV_B) * jax.nn.silu(r.astype(jnp.float32))
    return o.astype(h.dtype) @ w_out


def moe_ffn(h, router_w, router_b, w_gu, b_gu, w_down, b_down):
    B, S, D = h.shape
    n_tok = B * S
    t = h.reshape(n_tok, D)
    logits = (t @ router_w + router_b).astype(jnp.float32)
    top_v, top_i = lax.top_k(logits, TOP_K)
    gates = jax.nn.softmax(top_v, axis=-1)
    n_assign = n_tok * TOP_K
    flat_e = top_i.reshape(-1).astype(jnp.int32)
    flat_tok = jnp.repeat(jnp.arange(n_tok, dtype=jnp.int32), TOP_K)
    flat_w = gates.reshape(-1)
    order = jnp.argsort(flat_e)
    sorted_e = flat_e[order]
    counts = jnp.bincount(flat_e, length=N_EXPERTS)
    padded = (counts + EXPERT_BLOCK - 1) // EXPERT_BLOCK * EXPERT_BLOCK
    seg_end = jnp.cumsum(padded)
    rank = jnp.arange(n_assign, dtype=jnp.int32) - (jnp.cumsum(counts) - counts)[sorted_e]
    dest = (seg_end - padded)[sorted_e] + rank
    cap = n_assign + N_EXPERTS * EXPERT_BLOCK
    n_blocks = cap // EXPERT_BLOCK
    tok_buf = jnp.full((cap,), n_tok, jnp.int32).at[dest].set(flat_tok[order])
    w_buf = jnp.zeros((cap,), jnp.float32).at[dest].set(flat_w[order])
    block_e = jnp.minimum(
        jnp.searchsorted(seg_end, jnp.arange(n_blocks, dtype=jnp.int32) * EXPERT_BLOCK, side='right'),
        N_EXPERTS - 1)
    t_pad = jnp.concatenate([t, jnp.zeros((1, D), t.dtype)], axis=0)

    def expert_block(args):
        idx, e = args
        gu = (t_pad[idx] @ w_gu[e] + b_gu[e]).astype(jnp.float32)
        gate = jnp.minimum(gu[:, :D_FF], SWIGLU_LIMIT)
        up = jnp.clip(gu[:, D_FF:], -SWIGLU_LIMIT, SWIGLU_LIMIT)
        act = (up + 1.0) * (gate * jax.nn.sigmoid(SWIGLU_ALPHA * gate))
        return (act.astype(h.dtype) @ w_down[e] + b_down[e]).astype(jnp.float32)

    outs = lax.map(expert_block, (tok_buf.reshape(n_blocks, EXPERT_BLOCK), block_e))
    outs = outs.reshape(cap, D) * w_buf[:, None]
    y = jnp.zeros((n_tok + 1, D), jnp.float32).at[tok_buf].add(outs)[:n_tok]
    return y.astype(h.dtype).reshape(B, S, D)


def setup_inputs(seed: int = 0) -> dict:
    key = jax.random.key(seed)
    ks = jax.random.split(key, 22)
    D, E, F = D_MODEL, N_EXPERTS, D_FF

    def nrm(k, shape, scale):
        return jax.random.normal(k, shape, jnp.float32) * scale

    offsets = jax.random.randint(ks[2], (BATCH, 1), 0, MAX_POS_OFFSET, dtype=jnp.int32)
    positions = (offsets + jnp.arange(SEQ, dtype=jnp.int32)[None, :]).astype(jnp.int32)
    return {
        'x': nrm(ks[0], (BATCH, SEQ, D), 1.0),
        'c': nrm(ks[1], (BATCH, D), 1.0),
        'positions': positions,
        'ada_w': nrm(ks[3], (DEPTH, D, 6 * D), 0.5 * D ** -0.5),
        'ada_b': nrm(ks[4], (DEPTH, 6 * D), 0.02),
        'norm1_g': 1.0 + nrm(ks[5], (DEPTH, D), 0.02),
        'norm2_g': 1.0 + nrm(ks[6], (DEPTH, D), 0.02),
        'a_w_in': nrm(ks[7], (N_A_LAYERS, D, N_GROUPS_A * 3 * WIDTH_A), D ** -0.5),
        'a_q_gain': 1.0 + nrm(ks[8], (N_A_LAYERS, N_GROUPS_A, HEAD_DIM_A), 0.02),
        'a_k_gain': 1.0 + nrm(ks[9], (N_A_LAYERS, N_GROUPS_A, HEAD_DIM_A), 0.02),
        'a_w_out': nrm(ks[10], (N_A_LAYERS, WIDTH_A, D), WIDTH_A ** -0.5),
        'b_w_in': nrm(ks[11], (N_B_LAYERS, D, B_IN_WIDTH), D ** -0.5),
        'b_w_gate_up': nrm(ks[12], (N_B_LAYERS, GATE_RANK, HK_B), GATE_RANK ** -0.5),
        'b_gate_bias': nrm(ks[13], (N_B_LAYERS, HK_B), 0.1),
        'b_out_gain': 1.0 + nrm(ks[14], (N_B_LAYERS, VAL_DIM_B), 0.02),
        'b_w_out': nrm(ks[15], (N_B_LAYERS, HV_B, D), HV_B ** -0.5),
        'router_w': nrm(ks[16], (DEPTH, D, E), D ** -0.5),
        'router_b': nrm(ks[17], (DEPTH, E), 0.01),
        'moe_w_gu': nrm(ks[18], (DEPTH, E, D, 2 * F), D ** -0.5),
        'moe_b_gu': nrm(ks[19], (DEPTH, E, 2 * F), 0.02),
        'moe_w_down': nrm(ks[20], (DEPTH, E, F, D), F ** -0.5),
        'moe_b_down': nrm(ks[21], (DEPTH, E, D), 0.02),
    }


def reference(x, c, positions, ada_w, ada_b, norm1_g, norm2_g, a_w_in, a_q_gain, a_k_gain,
              a_w_out, b_w_in, b_w_gate_up, b_gate_bias, b_out_gain, b_w_out, router_w,
              router_b, moe_w_gu, moe_b_gu, moe_w_down, moe_b_down):
    cond = jax.nn.silu(c)
    for layer in range(DEPTH):
        mod = cond @ ada_w[layer] + ada_b[layer]
        shift1, scale1, gate1, shift2, scale2, gate2 = [m[:, None, :] for m in jnp.split(mod, 6, axis=-1)]
        h = rmsnorm(x, norm1_g[layer]) * (1.0 + scale1) + shift1
        j = layer // N_MIXERS
        if layer % N_MIXERS == 0:
            mix = dilated_mixer(h, positions, a_w_in[j], a_q_gain[j], a_k_gain[j], a_w_out[j])
        else:
            mix = gla_mixer(h, b_w_in[j], b_w_gate_up[j], b_gate_bias[j], b_out_gain[j], b_w_out[j])
        x = x + gate1 * mix
        h = rmsnorm(x, norm2_g[layer]) * (1.0 + scale2) + shift2
        x = x + gate2 * moe_ffn(h, router_w[layer], router_b[layer], moe_w_gu[layer],
                                moe_b_gu[layer], moe_w_down[layer], moe_b_down[layer])
    return x
```

```cpp
#include <hip/hip_runtime.h>
#include <cstdio>
#include <cstdint>

#define LAS __attribute__((address_space(3)))
#define GAS __attribute__((address_space(1)))
typedef unsigned short bf16_t;
typedef short bf16x8 __attribute__((ext_vector_type(8)));
typedef short s16x4 __attribute__((ext_vector_type(4)));
typedef float f32x2 __attribute__((ext_vector_type(2)));
typedef float f32x4 __attribute__((ext_vector_type(4)));
typedef float f32x16 __attribute__((ext_vector_type(16)));
typedef unsigned u32x2 __attribute__((ext_vector_type(2)));
typedef unsigned u32x4 __attribute__((ext_vector_type(4)));
typedef GAS unsigned gu32;

#ifndef MK_PER_PHASE
#define MK_PER_PHASE 0
#endif
#ifndef MK_PROBE
#define MK_PROBE 0
#endif
#ifndef MK_LAST_PHASE
#define MK_LAST_PHASE 99
#endif

constexpr int D = 1024, NB = 8, SEQ = 4096, NTOK = NB * SEQ;
constexpr int NQKV = 9216, NPROJ = 3072, BIN_PITCH = 3088;
constexpr int NE = 32, TOPK = 4, NASSIGN = NTOK * TOPK, ECAP = NTOK;
constexpr int ACT_ROWS = NASSIGN + NE * 256;
constexpr float RMS_EPS = 1e-6f;
constexpr float LOG2E = 1.4426950408889634f;

constexpr size_t MiB = 1u << 20;
constexpr size_t WS_CTL = 0, CTL_ZERO_BYTES = 1 * MiB;
constexpr size_t WS_MOD = 1 * MiB;
constexpr size_t WS_WAIN = 2 * MiB;
constexpr size_t WS_WAOUT = 20 * MiB;
constexpr size_t WS_WBIN = 22 * MiB;
constexpr size_t WS_WBOUT = 28 * MiB;
constexpr size_t WS_WTR = 30 * MiB;
constexpr size_t WS_WTA = 30 * MiB + 512 * 1024;
constexpr size_t WS_WGU = 32 * MiB;
constexpr size_t WS_WDN = 288 * MiB;
constexpr size_t WS_H = 416 * MiB;
constexpr size_t WS_O = 480 * MiB;
constexpr size_t WS_LSE = 544 * MiB;
constexpr size_t WS_APROJ = 546 * MiB;
constexpr size_t WS_GATEW = 548 * MiB;
constexpr size_t WS_TOKLIST = 549 * MiB;
constexpr size_t WS_XA = 556 * MiB;
constexpr size_t WS_R = 684 * MiB;
constexpr size_t WS_ACT = WS_R;
constexpr size_t WS_Y = WS_R + 272 * MiB;
constexpr size_t WS_END = WS_R + 576 * MiB;
static_assert((size_t)ACT_ROWS * 2048 <= 272 * MiB && (size_t)NASSIGN * 2048 <= 304 * MiB, "ws map");
constexpr int CW_TMO = 0, CW_CODE = 1, CW_BAR = 4096, CW_CNT = 8192;

constexpr int MISC_OFF = 0;
constexpr int TAB_OFF = 1024;
constexpr int SEL_OFF = 4096;
constexpr int RING_OFF = 8192;
constexpr int LDS_BYTES = 147456;

#define RLX_AGENT __ATOMIC_RELAXED, __HIP_MEMORY_SCOPE_AGENT
#define LDS_WAIT() asm volatile("s_waitcnt lgkmcnt(0)" ::: "memory")
#define VM_WAIT() asm volatile("s_waitcnt vmcnt(0)" ::: "memory")
__device__ __forceinline__ unsigned f2bf(float f) { unsigned u = __builtin_bit_cast(unsigned, f); return (u + 0x7fffu + ((u >> 16) & 1u)) >> 16; }
__device__ __forceinline__ unsigned pk2(float lo, float hi) { return f2bf(lo) | (f2bf(hi) << 16); }
__device__ __forceinline__ unsigned cvt_pk_bf16(float lo, float hi) { unsigned r; asm volatile("v_cvt_pk_bf16_f32 %0, %1, %2" : "=v"(r) : "v"(lo), "v"(hi)); return r; }
__device__ __forceinline__ float bflo(unsigned w) { return __builtin_bit_cast(float, w << 16); }
__device__ __forceinline__ float bfhi(unsigned w) { return __builtin_bit_cast(float, w & 0xffff0000u); }
__device__ __forceinline__ float wave_sum(float v) {
#pragma unroll
    for (int o = 1; o < 64; o <<= 1) v += __shfl_xor(v, o);
    return v;
}
__device__ __forceinline__ int crow(int r, int hi) { return (r & 3) + 8 * (r >> 2) + 4 * hi; }
__device__ __forceinline__ s16x4 tr_read(LAS const char* p) { typedef short v4i16_t __attribute__((ext_vector_type(4))); return __builtin_bit_cast(s16x4, __builtin_amdgcn_ds_read_tr16_b64_v4i16((LAS v4i16_t*)p)); }
#define CAT8(lo, hi) ((bf16x8){lo[0], lo[1], lo[2], lo[3], hi[0], hi[1], hi[2], hi[3]})

namespace pg8 {
constexpr int BM = 256, BK = 64, HALF = 128, HTB = HALF * BK * 2, STAGE_BYTES = 8 * HTB, KD = 1024, NT = KD / BK;
__host__ __device__ __forceinline__ int lds_byte(int r, int c) { const int st = (r >> 4) * 2 + (c >> 5), rr = r & 15, cc = c & 31, ob = rr * 64 + cc * 2; return st * 1024 + (ob ^ (((ob >> 9) & 1) << 5)); }
__host__ __device__ __forceinline__ void stage_rc(int b, int& R, int& C) { const int st = b / 1024, sb = b % 1024, swz = sb ^ (((sb >> 9) & 1) << 5); R = (st >> 1) * 16 + swz / 64; C = (st & 1) * 32 + (swz % 64) / 2; }

struct GUnit { int e, pm, pn, rows; };
typedef f32x4 Acc[2][2][4][2];

template <class Epi, class Sched>
__device__ __forceinline__ void gemm_phase(LAS unsigned char* lds, LAS unsigned* tab, const Sched& S, const Epi& E) {
    const int tid = threadIdx.x, wid = __builtin_amdgcn_readfirstlane(tid >> 6), lane = tid & 63, wr = wid >> 2, wc = wid & 3, fr = lane & 15, fq = lane >> 4;
    int sR[2], sC[2]; unsigned voffB[2];
#pragma unroll
    for (int i = 0; i < 2; ++i) { stage_rc(tid * 16 + i * 8192, sR[i], sC[i]); voffB[i] = (unsigned)(sR[i] * KD + sC[i]) * 2u; }
    constexpr unsigned kstep = BK * 2;
    constexpr size_t hstepB = (size_t)HALF * KD * 2;
    const unsigned ldsw = (unsigned)wid * 1024u;
    const int aoff = lds_byte(wr * 64 + fr, fq * 8), boff = lds_byte(wc * 32 + fr, fq * 8);
    const char* const Ab = S.abase();
#define PG8_SA(b, h) (((b) * 2 + (h)) * HTB)
#define PG8_SB(b, h) ((4 + (b) * 2 + (h)) * HTB)
#define PG8_STAGE_B(bufoff, gbase) do { _Pragma("unroll") for (int _i = 0; _i < 2; ++_i) \
        __builtin_amdgcn_global_load_lds((const unsigned*)((const char*)(gbase) + voffB[_i]), (LAS unsigned*)(lds + (bufoff) + ldsw + _i * 8192), 16, 0, 0); } while (0)
#define PG8_STAGE_A(bufoff, uah, koff) do { _Pragma("unroll") for (int _i = 0; _i < 2; ++_i) \
        __builtin_amdgcn_global_load_lds((const unsigned*)(Ab + (size_t)((uah)[_i]) + (size_t)(koff)), (LAS unsigned*)(lds + (bufoff) + ldsw + _i * 8192), 16, 0, 0); } while (0)
#define PG8_LDA(dst, b, h) do { _Pragma("unroll") for (int m = 0; m < 4; ++m) _Pragma("unroll") for (int k = 0; k < 2; ++k) dst[m][k] = *(const LAS bf16x8*)(lds + PG8_SA(b, h) + aoff + m * 2048 + k * 1024); } while (0)
#define PG8_LDB(dst, b, h) do { _Pragma("unroll") for (int n = 0; n < 2; ++n) _Pragma("unroll") for (int k = 0; k < 2; ++k) dst[n][k] = *(const LAS bf16x8*)(lds + PG8_SB(b, h) + boff + n * 2048 + k * 1024); } while (0)
#define PG8_MMA(ai, bj, At, Bt) do { __builtin_amdgcn_s_setprio(1); _Pragma("unroll") for (int m = 0; m < 4; ++m) _Pragma("unroll") for (int n = 0; n < 2; ++n) _Pragma("unroll") for (int k = 0; k < 2; ++k) \
        acc[ai][bj][m][n] = __builtin_amdgcn_mfma_f32_16x16x32_bf16(Bt[n][k], At[m][k], acc[ai][bj][m][n], 0, 0, 0); __builtin_amdgcn_s_setprio(0); } while (0)
#define PG8_WAIT_V(n) asm volatile("s_waitcnt vmcnt(" #n ")" ::: "memory")
#define PG8_WAIT_L(n) asm volatile("s_waitcnt lgkmcnt(" #n ")" ::: "memory")
#define PG8_BAR __builtin_amdgcn_s_barrier()
#define PG8_SCHED __builtin_amdgcn_sched_barrier(0)
    GUnit cur, nxt; int ui = 0;
    if (!S.next(0, cur)) return;
    Acc acc;
#pragma unroll
    for (int a = 0; a < 2; ++a)
#pragma unroll
        for (int b = 0; b < 2; ++b)
#pragma unroll
            for (int m = 0; m < 4; ++m)
#pragma unroll
                for (int n = 0; n < 2; ++n) acc[a][b][m][n] = (f32x4){0.f, 0.f, 0.f, 0.f};
    bf16x8 At[4][2], B0[2][2], B1[2][2];
    unsigned uaC[2][2], uaN[2][2];
    if constexpr (Sched::TAB) { S.issue_tab(cur, tab, wid, lane); PG8_WAIT_V(0); __syncthreads(); }
    S.aoffs(cur, tab, sR, sC, uaC);
    const char* cB = S.bbase(cur);
    PG8_STAGE_B(PG8_SB(0, 0), cB); PG8_STAGE_B(PG8_SB(0, 1), cB + hstepB); PG8_STAGE_A(PG8_SA(0, 0), uaC[0], 0); PG8_STAGE_A(PG8_SA(0, 1), uaC[1], 0);
    if (wr == 1) PG8_BAR;
    PG8_WAIT_V(2); PG8_BAR;
    PG8_STAGE_B(PG8_SB(1, 0), cB + kstep); PG8_STAGE_A(PG8_SA(1, 0), uaC[0], kstep); PG8_STAGE_B(PG8_SB(1, 1), cB + hstepB + kstep);
    PG8_WAIT_V(6); PG8_BAR;
    for (;;) {
        const bool has_next = S.next(ui + 1, nxt);
        LAS unsigned* const tabN = tab + ((ui + 1) % 3) * 256;
        if constexpr (Sched::TAB) { if (has_next) S.issue_tab(nxt, tabN, wid, lane); }
        const char* nB = has_next ? S.bbase(nxt) : cB;
        for (int t = 0; t < NT; t += 2) {
            const bool last = (t == NT - 2);
            if (last) { if (has_next) S.aoffs(nxt, tabN, sR, sC, uaN); else {
#pragma unroll
                for (int h = 0; h < 2; ++h)
#pragma unroll
                    for (int i = 0; i < 2; ++i) uaN[h][i] = uaC[h][i]; } }
            unsigned u2[2][2];
#pragma unroll
            for (int h = 0; h < 2; ++h)
#pragma unroll
                for (int i = 0; i < 2; ++i) u2[h][i] = last ? uaN[h][i] : uaC[h][i];
            const unsigned k1 = (unsigned)(t + 1) * kstep, k2 = last ? 0u : (unsigned)(t + 2) * kstep;
            const char* b2 = last ? nB : cB + (size_t)(t + 2) * kstep; const char* b3 = b2 + kstep;
            PG8_LDB(B0, 0, 0); PG8_LDB(B1, 0, 1); PG8_SCHED; PG8_LDA(At, 0, 0); PG8_STAGE_A(PG8_SA(1, 1), uaC[1], k1);
            PG8_WAIT_V(8); PG8_WAIT_L(0); PG8_BAR; PG8_MMA(0, 0, At, B0); PG8_MMA(0, 1, At, B1); PG8_BAR; PG8_SCHED;
            PG8_LDA(At, 0, 1); PG8_STAGE_B(PG8_SB(0, 0), b2); PG8_STAGE_B(PG8_SB(0, 1), b2 + hstepB); PG8_STAGE_A(PG8_SA(0, 0), u2[0], k2);
            PG8_WAIT_V(8); PG8_WAIT_L(0); PG8_BAR; PG8_MMA(1, 0, At, B0); PG8_MMA(1, 1, At, B1); PG8_BAR; PG8_SCHED;
            PG8_LDB(B0, 1, 0); PG8_LDB(B1, 1, 1); PG8_SCHED; PG8_LDA(At, 1, 0); PG8_STAGE_A(PG8_SA(0, 1), u2[1], k2);
            PG8_WAIT_V(8); PG8_WAIT_L(0); PG8_BAR; PG8_MMA(0, 0, At, B0); PG8_MMA(0, 1, At, B1); PG8_BAR; PG8_SCHED;
            PG8_LDA(At, 1, 1); PG8_STAGE_B(PG8_SB(1, 0), b3); PG8_STAGE_B(PG8_SB(1, 1), b3 + hstepB); PG8_STAGE_A(PG8_SA(1, 0), u2[0], k2 + kstep);
            PG8_WAIT_V(8); PG8_WAIT_L(0); PG8_BAR; PG8_MMA(1, 0, At, B0); PG8_MMA(1, 1, At, B1); PG8_BAR; PG8_SCHED;
        }
        if (wr == 0) PG8_BAR;
        E(acc, cur, wr, wc, fr, fq, tab + (ui % 3) * 256);
        if (!has_next) break;
#pragma unroll
        for (int a = 0; a < 2; ++a)
#pragma unroll
            for (int b = 0; b < 2; ++b)
#pragma unroll
                for (int m = 0; m < 4; ++m)
#pragma unroll
                    for (int n = 0; n < 2; ++n) acc[a][b][m][n] = (f32x4){0.f, 0.f, 0.f, 0.f};
        cur = nxt; cB = nB; ++ui;
#pragma unroll
        for (int h = 0; h < 2; ++h)
#pragma unroll
            for (int i = 0; i < 2; ++i) uaC[h][i] = uaN[h][i];
        if (wr == 1) PG8_BAR;
    }
    PG8_WAIT_V(0);
    PG8_BAR;
#undef PG8_SA
#undef PG8_SB
#undef PG8_STAGE_A
#undef PG8_STAGE_B
#undef PG8_LDA
#undef PG8_LDB
#undef PG8_MMA
#undef PG8_WAIT_V
#undef PG8_WAIT_L
#undef PG8_BAR
#undef PG8_SCHED
}

constexpr int NXCD = 8, WGM = 8;
struct DenseSched {
    static constexpr bool TAB = false;
    const bf16_t* A; const bf16_t* Bt; int nM, nN, nwg, G, c, lda;
    __device__ __forceinline__ void init(const bf16_t* A_, const bf16_t* Bt_, int M, int N, int G_, int c_, int lda_ = KD) { A = A_; Bt = Bt_; nM = M / BM; nN = N / BM; nwg = nM * nN; G = G_; c = c_; lda = lda_; }
    __device__ __forceinline__ bool next(int i, GUnit& u) const {
        const long L = (long)i * G + c; if (L >= nwg) return false;
        int wgid = (int)L; { const int q = nwg / NXCD, r = nwg % NXCD, xcd = wgid % NXCD, off = wgid / NXCD; wgid = (xcd < r ? xcd * (q + 1) : r * (q + 1) + (xcd - r) * q) + off; }
        const int nig = WGM * nN, gid = wgid / nig, fm = gid * WGM, gsz = (nM - fm) < WGM ? (nM - fm) : WGM;
        u.pm = fm + ((wgid % nig) % gsz); u.pn = (wgid % nig) / gsz; u.e = 0; u.rows = 256; return true;
    }
    __device__ __forceinline__ const char* abase() const { return (const char*)A; }
    __device__ __forceinline__ const char* bbase(const GUnit& u) const { return (const char*)Bt + (size_t)u.pn * (BM * KD * 2); }
    __device__ __forceinline__ void issue_tab(const GUnit&, LAS unsigned*, int, int) const {}
    __device__ __forceinline__ void aoffs(const GUnit& u, LAS unsigned*, const int (&sR)[2], const int (&sC)[2], unsigned (&ua)[2][2]) const {
#pragma unroll
        for (int h = 0; h < 2; ++h)
#pragma unroll
            for (int i = 0; i < 2; ++i) ua[h][i] = (unsigned)((u.pm * BM + h * HALF + sR[i]) * lda + sC[i]) * 2u;
    }
};
template <bool GATHER> struct MoeSched {
    static constexpr bool TAB = true;
    const LAS int* ulist; int nunits; const LAS int* tstart; const LAS int* ecnt;
    const bf16_t* A; const bf16_t* Wt; size_t wstride; const unsigned* toklist;
    __device__ __forceinline__ bool next(int i, GUnit& u) const {
        if (i >= nunits) return false; const int v = ulist[i]; u.e = v & 255; u.pm = (v >> 8) & 4095; u.pn = v >> 20;
        const int rem = ecnt[u.e] - u.pm * 256; u.rows = rem < 256 ? rem : 256; return true;
    }
    __device__ __forceinline__ const char* abase() const { return (const char*)A; }
    __device__ __forceinline__ const char* bbase(const GUnit& u) const { return (const char*)Wt + (size_t)u.e * wstride + (size_t)u.pn * (BM * KD * 2); }
    __device__ __forceinline__ void issue_tab(const GUnit& u, LAS unsigned* t, int wid, int lane) const {
        if (wid < 4) __builtin_amdgcn_global_load_lds((const unsigned*)(toklist + (size_t)u.e * ECAP + u.pm * 256 + wid * 64 + lane), (LAS unsigned*)(t + wid * 64), 4, 0, 0);
    }
    __device__ __forceinline__ void aoffs(const GUnit& u, LAS unsigned* t, const int (&sR)[2], const int (&sC)[2], unsigned (&ua)[2][2]) const {
#pragma unroll
        for (int h = 0; h < 2; ++h)
#pragma unroll
            for (int i = 0; i < 2; ++i) {
                const int r = h * HALF + sR[i];
                if constexpr (GATHER) { const unsigned s = t[r < u.rows ? r : 0]; ua[h][i] = (s >> 2) * (unsigned)(KD * 2) + (unsigned)sC[i] * 2u; }
                else ua[h][i] = (unsigned)(((tstart[u.e] + u.pm) * BM + r) * KD + sC[i]) * 2u;
            }
    }
};

struct EpiBf16Plain {
    bf16_t* O; int ldc;
    __device__ __forceinline__ void operator()(const Acc& acc, const GUnit& u, int wr, int wc, int fr, int fq, LAS unsigned*) const {
        const int row0 = u.pm * BM + wr * 64 + fr, col0 = u.pn * BM + wc * 64 + fq * 8;
#pragma unroll
        for (int ai = 0; ai < 2; ++ai)
#pragma unroll
            for (int m = 0; m < 4; ++m) { bf16_t* rowp = O + (size_t)(row0 + ai * HALF + m * 16) * ldc + col0;
#pragma unroll
                for (int bj = 0; bj < 2; ++bj) { const f32x4 v0 = acc[ai][bj][m][0], v1 = acc[ai][bj][m][1];
                    u32x4 w; w.x = cvt_pk_bf16(v0[0], v0[1]); w.y = cvt_pk_bf16(v0[2], v0[3]); w.z = cvt_pk_bf16(v1[0], v1[1]); w.w = cvt_pk_bf16(v1[2], v1[3]);
                    *(u32x4*)(rowp + bj * 32) = w; } }
    }
};
struct EpiQKV {
    bf16_t* O; const int* pos; const float* qg; const float* kg;
    __device__ __forceinline__ void operator()(const Acc& acc, const GUnit& u, int wr, int wc, int fr, int fq, LAS unsigned*) const {
        const int g = u.pn / 12, s = (u.pn % 12) >> 2;
        const int row0 = u.pm * BM + wr * 64 + fr, col0 = u.pn * BM + wc * 64 + fq * 8;
        if (s == 2) {
#pragma unroll
            for (int ai = 0; ai < 2; ++ai)
#pragma unroll
                for (int m = 0; m < 4; ++m) { bf16_t* rowp = O + (size_t)(row0 + ai * HALF + m * 16) * NQKV + col0;
#pragma unroll
                    for (int bj = 0; bj < 2; ++bj) { const f32x4 v0 = acc[ai][bj][m][0], v1 = acc[ai][bj][m][1];
                        u32x4 w; w.x = cvt_pk_bf16(v0[0], v0[1]); w.y = cvt_pk_bf16(v0[2], v0[3]); w.z = cvt_pk_bf16(v1[0], v1[1]); w.w = cvt_pk_bf16(v1[2], v1[3]);
                        *(u32x4*)(rowp + bj * 32) = w; } }
            return;
        }
        const float* gain = (s == 0 ? qg : kg) + g * 64; const float sc = (s == 0) ? 0.125f * LOG2E : 1.0f;
#pragma unroll
        for (int ai = 0; ai < 2; ++ai)
#pragma unroll
            for (int m = 0; m < 4; ++m) {
                const int row = row0 + ai * HALF + m * 16; const float p = (float)pos[row];
                int gofs = 8 * fq; asm volatile("" : "+v"(gofs));
                const f32x4 ga = *(const f32x4*)(gain + gofs), gb = *(const f32x4*)(gain + gofs + 4), gc = *(const f32x4*)(gain + gofs + 32), gd = *(const f32x4*)(gain + gofs + 36);
                float v1[8], v2[8]; float ss = 0.f;
#pragma unroll
                for (int n = 0; n < 2; ++n)
#pragma unroll
                    for (int j = 0; j < 4; ++j) { v1[4 * n + j] = acc[ai][0][m][n][j]; v2[4 * n + j] = acc[ai][1][m][n][j]; ss += v1[4 * n + j] * v1[4 * n + j] + v2[4 * n + j] * v2[4 * n + j]; }
                ss += __shfl_xor(ss, 16); ss += __shfl_xor(ss, 32);
                const float rinv = __builtin_amdgcn_rsqf(ss * (1.0f / 64.0f) + RMS_EPS) * sc;
                float o1[8], o2[8];
#pragma unroll
                for (int i = 0; i < 8; ++i) { const float t1 = v1[i] * rinv * (i < 4 ? ga[i & 3] : gb[i & 3]), t2 = v2[i] * rinv * (i < 4 ? gc[i & 3] : gd[i & 3]);
                    const float invf = __builtin_amdgcn_exp2f(-(float)(gofs + i) * (13.287712379549449f / 32.0f)) * 0.15915494309189535f;
                    const float rev = __builtin_amdgcn_fractf(p * invf); const float cs = __builtin_amdgcn_cosf(rev), sn = __builtin_amdgcn_sinf(rev);
                    o1[i] = t1 * cs - t2 * sn; o2[i] = t2 * cs + t1 * sn; }
                bf16_t* rowp = O + (size_t)row * NQKV + col0;
                u32x4 w; w.x = cvt_pk_bf16(o1[0], o1[1]); w.y = cvt_pk_bf16(o1[2], o1[3]); w.z = cvt_pk_bf16(o1[4], o1[5]); w.w = cvt_pk_bf16(o1[6], o1[7]);
                *(u32x4*)(rowp) = w;
                w.x = cvt_pk_bf16(o2[0], o2[1]); w.y = cvt_pk_bf16(o2[2], o2[3]); w.z = cvt_pk_bf16(o2[4], o2[5]); w.w = cvt_pk_bf16(o2[6], o2[7]);
                *(u32x4*)(rowp + 32) = w;
                __builtin_amdgcn_sched_barrier(0);
            }
    }
};
struct EpiResid {
    const float* Xi; float* Xo; const float* gate;
    __device__ __forceinline__ void operator()(const Acc& acc, const GUnit& u, int wr, int wc, int fr, int fq, LAS unsigned*) const {
        const int row0 = u.pm * BM + wr * 64 + fr, col0 = u.pn * BM + wc * 32 + 4 * fq;
        const float* gp = gate + (size_t)((u.pm * BM) / SEQ) * 6144 + col0;
        f32x4 gv[2][2];
#pragma unroll
        for (int bj = 0; bj < 2; ++bj)
#pragma unroll
            for (int n = 0; n < 2; ++n) gv[bj][n] = *(const f32x4*)(gp + bj * HALF + n * 16);
#pragma unroll
        for (int ai = 0; ai < 2; ++ai)
#pragma unroll
            for (int m = 0; m < 4; ++m) { const size_t off = (size_t)(row0 + ai * HALF + m * 16) * D + col0;
#pragma unroll
                for (int bj = 0; bj < 2; ++bj)
#pragma unroll
                    for (int n = 0; n < 2; ++n) { const f32x4 xi = *(const f32x4*)(Xi + off + bj * HALF + n * 16); *(f32x4*)(Xo + off + bj * HALF + n * 16) = xi + gv[bj][n] * acc[ai][bj][m][n]; }
                asm volatile("" ::: "memory"); }
    }
};
struct EpiGLU {
    bf16_t* ACT; const float* bias; const LAS int* tstart;
    __device__ __forceinline__ void operator()(const Acc& acc, const GUnit& u, int wr, int wc, int fr, int fq, LAS unsigned*) const {
        const int c0 = u.pn * 128 + wc * 32 + fq * 8; const float* bp = bias + (size_t)u.e * 2048 + c0;
        const f32x4 bg0 = *(const f32x4*)(bp), bg1 = *(const f32x4*)(bp + 4), bu0 = *(const f32x4*)(bp + 1024), bu1 = *(const f32x4*)(bp + 1028);
        const size_t arow0 = (size_t)(tstart[u.e] + u.pm) * BM + wr * 64 + fr;
#pragma unroll
        for (int ai = 0; ai < 2; ++ai)
#pragma unroll
            for (int m = 0; m < 4; ++m) {
                const f32x4 ga = acc[ai][0][m][0] + bg0, gb = acc[ai][0][m][1] + bg1, ua = acc[ai][1][m][0] + bu0, ub = acc[ai][1][m][1] + bu1;
                float o[8];
#pragma unroll
                for (int j = 0; j < 4; ++j) {
                    { const float gt = __builtin_fminf(ga[j], 7.0f), up = __builtin_fminf(__builtin_fmaxf(ua[j], -7.0f), 7.0f);
                      const float sg = __builtin_amdgcn_rcpf(1.0f + __builtin_amdgcn_exp2f(-1.702f * LOG2E * gt)); o[j] = (up + 1.0f) * (gt * sg); }
                    { const float gt = __builtin_fminf(gb[j], 7.0f), up = __builtin_fminf(__builtin_fmaxf(ub[j], -7.0f), 7.0f);
                      const float sg = __builtin_amdgcn_rcpf(1.0f + __builtin_amdgcn_exp2f(-1.702f * LOG2E * gt)); o[4 + j] = (up + 1.0f) * (gt * sg); }
                }
                u32x4 w; w.x = cvt_pk_bf16(o[0], o[1]); w.y = cvt_pk_bf16(o[2], o[3]); w.z = cvt_pk_bf16(o[4], o[5]); w.w = cvt_pk_bf16(o[6], o[7]);
                *(u32x4*)(ACT + (arow0 + ai * HALF + m * 16) * D + c0) = w;
            }
    }
};
struct EpiDown {
    bf16_t* Y; const float* bias; const float* gatew;
    __device__ __forceinline__ void operator()(const Acc& acc, const GUnit& u, int wr, int wc, int fr, int fq, LAS unsigned* tab) const {
        const int col0 = u.pn * BM + wc * 64 + fq * 8; const float* bp = bias + (size_t)u.e * D + col0;
        f32x4 bv[2][2];
#pragma unroll
        for (int bj = 0; bj < 2; ++bj)
#pragma unroll
            for (int n = 0; n < 2; ++n) bv[bj][n] = *(const f32x4*)(bp + bj * 32 + n * 4);
#pragma unroll
        for (int ai = 0; ai < 2; ++ai)
#pragma unroll
            for (int m = 0; m < 4; ++m) {
                const int r = ai * HALF + wr * 64 + m * 16 + fr;
                if (r < u.rows) {
                    const unsigned slot = tab[r]; const float w = gatew[slot]; bf16_t* rowp = Y + (size_t)slot * D + col0;
#pragma unroll
                    for (int bj = 0; bj < 2; ++bj) { const f32x4 v0 = (acc[ai][bj][m][0] + bv[bj][0]) * w, v1 = (acc[ai][bj][m][1] + bv[bj][1]) * w;
                        u32x4 o; o.x = cvt_pk_bf16(v0[0], v0[1]); o.y = cvt_pk_bf16(v0[2], v0[3]); o.z = cvt_pk_bf16(v1[0], v1[1]); o.w = cvt_pk_bf16(v1[2], v1[3]);
                        *(u32x4*)(rowp + bj * 32) = o; }
                }
            }
    }
};
}

#define XB_TMO      128
#define XB_XCNT(j)  (256  + 64 * (j))
#define XB_XSUB(j)  (1280 + 64 * (j))
#define XB_XGEN(j)  (2304 + 64 * (j))
#define XB_TOP      3328
#define XB_TOPGEN   3392
#define XCD_BAR_WORDS 3456
#define XB_SPIN_CAP (1u << 18)
__device__ __forceinline__ unsigned xb_ld(unsigned* p)              { return __hip_atomic_load(p, __ATOMIC_RELAXED, __HIP_MEMORY_SCOPE_AGENT); }
__device__ __forceinline__ unsigned xb_add(unsigned* p, unsigned v) { return __hip_atomic_fetch_add(p, v, __ATOMIC_RELAXED, __HIP_MEMORY_SCOPE_AGENT); }
__device__ __forceinline__ unsigned xb_xcc_id() { return (unsigned)__builtin_amdgcn_s_getreg((3 << 11) | 20) & 0xFu; }
#define XB_SPIN(cond, bar) do { unsigned _sp = 0; while (cond) { __builtin_amdgcn_s_sleep(1); \
    if ((++_sp & 255u) == 0u) { if (xb_ld(&(bar)[XB_TMO])) break; if (_sp > XB_SPIN_CAP) { atomicAdd(&(bar)[XB_TMO], 1u); break; } } } } while (0)
struct XcdBarrier { unsigned* bar; unsigned x; volatile LAS unsigned* st; };
__device__ __forceinline__ XcdBarrier xcd_barrier_post(unsigned* bar, volatile LAS unsigned* st) {
    XcdBarrier b; b.bar = bar; b.x = xb_xcc_id(); b.st = st;
    if (threadIdx.x == 0) (void)xb_add(&bar[XB_XCNT(b.x)], 1u);
    return b;
}
__device__ __forceinline__ void xcd_barrier_complete(unsigned* bar, unsigned x, unsigned& nloc, unsigned& nx) {
    const unsigned G = gridDim.x * gridDim.y * gridDim.z;
    unsigned sum, cnt, mine, sp = 0u;
    for (;;) {
        sum = 0u; cnt = 0u; mine = 0u;
#pragma unroll
        for (unsigned j = 0; j < 16; ++j) { const unsigned c = xb_ld(&bar[XB_XCNT(j)]); sum += c; cnt += (c > 0u) ? 1u : 0u; mine = (j == x) ? c : mine; }
        if (sum == G) break;
        __builtin_amdgcn_s_sleep(1);
        if ((++sp & 255u) == 0u) { if (xb_ld(&bar[XB_TMO])) break; if (sp > XB_SPIN_CAP) { atomicAdd(&bar[XB_TMO], 1u); break; } }
    }
    nloc = mine > 0u ? mine : 1u; nx = cnt > 0u ? cnt : 1u;
}
__device__ __forceinline__ void xcd_barrier(const XcdBarrier& b) {
    asm volatile("s_waitcnt vmcnt(0)" ::: "memory");
    __syncthreads();
    if (threadIdx.x == 0) {
        unsigned* bar = b.bar;
        __builtin_amdgcn_s_waitcnt(0);
        unsigned nloc = b.st[0], nx = b.st[1];
        if (nloc == 0u) { xcd_barrier_complete(bar, b.x, nloc, nx); b.st[0] = nloc; b.st[1] = nx; }
        const unsigned old = xb_add(&bar[XB_XSUB(b.x)], 1u);
        const unsigned gen = old / nloc;
        if (old + 1u == (gen + 1u) * nloc) {
            __builtin_amdgcn_fence(__ATOMIC_RELEASE, "agent");
            asm volatile("s_waitcnt vmcnt(0)" ::: "memory");
            const unsigned og = xb_add(&bar[XB_TOP], 1u);
            const unsigned tg = og / nx;
            if (og + 1u == (tg + 1u) * nx) xb_add(&bar[XB_TOPGEN], 1u);
            else XB_SPIN(xb_ld(&bar[XB_TOPGEN]) == tg, bar);
            __builtin_amdgcn_fence(__ATOMIC_ACQUIRE, "agent");
            xb_add(&bar[XB_XGEN(b.x)], 1u);
            asm volatile("s_waitcnt vmcnt(0)" ::: "memory");
        } else {
            XB_SPIN(xb_ld(&bar[XB_XGEN(b.x)]) == gen, bar);
            __builtin_amdgcn_fence(__ATOMIC_ACQUIRE, "agent");
            asm volatile("s_waitcnt vmcnt(0)" ::: "memory");
        }
    }
    __syncthreads();
}

struct Args { const void* in[22]; float* out; unsigned char* ws; int ph_lo, ph_hi; };
#define A_x ((const float*)A.in[0])
#define A_c ((const float*)A.in[1])
#define A_pos ((const int*)A.in[2])
#define A_ada_w ((const float*)A.in[3])
#define A_ada_b ((const float*)A.in[4])
#define A_n1g ((const float*)A.in[5])
#define A_n2g ((const float*)A.in[6])
#define A_a_w_in ((const float*)A.in[7])
#define A_a_qg ((const float*)A.in[8])
#define A_a_kg ((const float*)A.in[9])
#define A_a_w_out ((const float*)A.in[10])
#define A_b_w_in ((const float*)A.in[11])
#define A_b_wg ((const float*)A.in[12])
#define A_b_gb ((const float*)A.in[13])
#define A_b_og ((const float*)A.in[14])
#define A_b_w_out ((const float*)A.in[15])
#define A_r_w ((const float*)A.in[16])
#define A_r_b ((const float*)A.in[17])
#define A_w_gu ((const float*)A.in[18])
#define A_b_gu ((const float*)A.in[19])
#define A_w_dn ((const float*)A.in[20])
#define A_b_dn ((const float*)A.in[21])
#define A_out (A.out)
#define A_mod ((float*)(A.ws + WS_MOD))
#define A_WTR ((bf16_t*)(A.ws + WS_WTR))
#define A_WTA ((bf16_t*)(A.ws + WS_WTA))
#define A_WAIN ((bf16_t*)(A.ws + WS_WAIN))
#define A_WAOUT ((bf16_t*)(A.ws + WS_WAOUT))
#define A_WBIN ((bf16_t*)(A.ws + WS_WBIN))
#define A_WBOUT ((bf16_t*)(A.ws + WS_WBOUT))
#define A_WGU ((bf16_t*)(A.ws + WS_WGU))
#define A_WDN ((bf16_t*)(A.ws + WS_WDN))
#define A_H ((bf16_t*)(A.ws + WS_H))
#define A_O ((bf16_t*)(A.ws + WS_O))
#define A_QKV ((bf16_t*)(A.ws + WS_R))
#define A_ACT ((bf16_t*)(A.ws + WS_ACT))
#define A_Y ((bf16_t*)(A.ws + WS_Y))
#define A_PROJ ((bf16_t*)(A.ws + WS_R))
#define A_LSE ((float*)(A.ws + WS_LSE))
#define A_APROJ ((float*)(A.ws + WS_APROJ))
#define A_GATEW ((float*)(A.ws + WS_GATEW))
#define A_XA ((float*)(A.ws + WS_XA))
#define A_TOKLIST ((unsigned*)(A.ws + WS_TOKLIST))
struct Frame {
    LAS unsigned char* lds;
    volatile LAS unsigned* MISC;
    gu32* ctl;
    int tid, lane, wave, G;
};
constexpr int NWAVES = 8;

__device__ __forceinline__ int perm5(int i) { return (((i >> 2) & 1) << 4) | ((i >> 3) << 2) | (i & 3); }
template <int MODE> __device__ __forceinline__ int dest_row(int n) {
    if (MODE == 0) return n;
    if (MODE == 1) return (n & ~255) | (((n >> 5) & 1) << 7) | (((n >> 6) & 3) << 5) | perm5(n & 31);
    const int bj = n >> 10, j = n & 1023; return ((j >> 7) << 8) | (bj << 7) | (((j >> 5) & 3) << 5) | perm5(j & 31);
}
template <int MODE> __device__ __forceinline__ void p0_transpose_item(const float* W, int ldw, int N, bf16_t* WT, LAS float* scr, int item, int lane) {
    const int nblk = N / 32, kb = item / nblk, nb = item % nblk, k0 = 64 * kb, n0 = 32 * nb;
#pragma unroll 8
    for (int i = 0; i < 32; ++i) { const int kk = 2 * i + (lane >> 5); scr[kk * 33 + (lane & 31)] = W[(size_t)(k0 + kk) * ldw + n0 + (lane & 31)]; }
    LDS_WAIT(); asm volatile("" ::: "memory");
    const int c = lane & 7;
#pragma unroll
    for (int j = 0; j < 4; ++j) { const int n = (lane >> 3) + 8 * j; const LAS float* s = scr + (8 * c) * 33 + n;
        u32x4 o; o.x = pk2(s[0 * 33], s[1 * 33]); o.y = pk2(s[2 * 33], s[3 * 33]); o.z = pk2(s[4 * 33], s[5 * 33]); o.w = pk2(s[6 * 33], s[7 * 33]);
        *(GAS u32x4*)(WT + (size_t)dest_row<MODE>(n0 + n) * 1024 + k0 + 8 * c) = o; }
    LDS_WAIT(); asm volatile("" ::: "memory");
}
__device__ __forceinline__ void p0_prologue(Frame& F, const Args& A) {
    LAS float* cond = (LAS float*)(F.lds + RING_OFF);
    for (int idx = F.tid; idx < NB * D; idx += NWAVES * 64) { const int b = idx >> 10, k = idx & 1023; const float v = A_c[idx]; cond[k * 8 + b] = v / (1.0f + __expf(-v)); }
    __syncthreads();
    const int gw = blockIdx.x * NWAVES + F.wave, NGW = F.G * NWAVES;
    for (int it = gw; it < 2 * 192; it += NGW) {
        const int l = it / 192, nb = it % 192, col = 32 * nb + (F.lane & 31), kh = F.lane >> 5;
        float acc[8];
#pragma unroll
        for (int b = 0; b < 8; ++b) acc[b] = 0.f;
        const float* wp = A_ada_w + ((size_t)l * D + kh * 512) * 6144 + col;
#pragma unroll 8
        for (int k = 0; k < 512; ++k) { const float w = wp[(size_t)k * 6144]; const f32x4 c0 = *(const LAS f32x4*)(cond + (kh * 512 + k) * 8), c1 = *(const LAS f32x4*)(cond + (kh * 512 + k) * 8 + 4);
            acc[0] += c0[0] * w; acc[1] += c0[1] * w; acc[2] += c0[2] * w; acc[3] += c0[3] * w; acc[4] += c1[0] * w; acc[5] += c1[1] * w; acc[6] += c1[2] * w; acc[7] += c1[3] * w; }
#pragma unroll
        for (int b = 0; b < 8; ++b) acc[b] += __shfl_xor(acc[b], 32);
        if (kh == 0) { const float bias = A_ada_b[l * 6144 + col];
#pragma unroll
            for (int b = 0; b < 8; ++b) A_mod[(size_t)(l * 8 + b) * 6144 + col] = acc[b] + bias; }
    }
    __syncthreads();
    LAS float* scr = (LAS float*)(F.lds + RING_OFF + F.wave * 16384);
    constexpr int I_AIN = 16 * (NQKV / 32), I_SQ = 16 * 32, I_BIN = 16 * (NPROJ / 32), I_GU = 16 * 64, I_DN = 16 * 32;
    constexpr int NITEMS = I_AIN + I_SQ + I_BIN + I_SQ + 64 * I_GU + 64 * I_DN;
    for (int it = gw; it < NITEMS; it += NGW) {
        int r = it;
        if (r < I_AIN) { p0_transpose_item<1>(A_a_w_in, NQKV, NQKV, A_WAIN, scr, r, F.lane); continue; } r -= I_AIN;
        if (r < I_SQ) { p0_transpose_item<0>(A_a_w_out, D, D, A_WAOUT, scr, r, F.lane); continue; } r -= I_SQ;
        if (r < I_BIN) { p0_transpose_item<1>(A_b_w_in, BIN_PITCH, NPROJ, A_WBIN, scr, r, F.lane); continue; } r -= I_BIN;
        if (r < I_SQ) { p0_transpose_item<0>(A_b_w_out, D, D, A_WBOUT, scr, r, F.lane); continue; } r -= I_SQ;
        if (r < 64 * I_GU) { const int mtx = r / I_GU; p0_transpose_item<2>(A_w_gu + (size_t)mtx * D * 2048, 2048, 2048, A_WGU + (size_t)mtx * 2048 * 1024, scr, r % I_GU, F.lane); continue; } r -= 64 * I_GU;
        { const int mtx = r / I_DN; p0_transpose_item<1>(A_w_dn + (size_t)mtx * D * D, D, D, A_WDN + (size_t)mtx * 1024 * 1024, scr, r % I_DN, F.lane); }
    }
    for (int idx = blockIdx.x * (NWAVES * 64) + F.tid; idx < 2 * 32 * 1024 + 16 * 1024; idx += F.G * NWAVES * 64) {
        if (idx < 2 * 32 * 1024) { const int l = idx >> 15, e = (idx >> 10) & 31, k = idx & 1023; const float v = A_r_w[((size_t)l * D + k) * NE + e];
            const unsigned h = f2bf(v); A_WTR[((size_t)(l * 2) * 32 + e) * 1024 + k] = (bf16_t)h; A_WTR[((size_t)(l * 2 + 1) * 32 + e) * 1024 + k] = (bf16_t)f2bf(v - __builtin_bit_cast(float, h << 16)); }
        else { const int i2 = idx - 2 * 32 * 1024, e = i2 >> 10, k = i2 & 1023; const float v = A_b_w_in[(size_t)k * BIN_PITCH + NPROJ + e];
            const unsigned h = f2bf(v); A_WTA[(size_t)e * 1024 + k] = (bf16_t)h; A_WTA[(size_t)(16 + e) * 1024 + k] = (bf16_t)f2bf(v - __builtin_bit_cast(float, h << 16)); }
    }
}

__device__ __forceinline__ void load_row(const float* p, int lane, f32x4 (&v)[4]) {
    const GAS f32x4* r = (const GAS f32x4*)p + lane;
#pragma unroll
    for (int j = 0; j < 4; ++j) v[j] = r[64 * j];
}
__device__ __forceinline__ void store_row(float* p, int lane, const f32x4 (&v)[4]) {
    GAS f32x4* r = (GAS f32x4*)p + lane;
#pragma unroll
    for (int j = 0; j < 4; ++j) r[64 * j] = v[j];
}
__device__ __forceinline__ void store_row_bf16(bf16_t* p, int lane, const f32x4 (&v)[4]) {
    GAS u32x2* r = (GAS u32x2*)p + lane;
#pragma unroll
    for (int j = 0; j < 4; ++j) { u32x2 w; w.x = pk2(v[j][0], v[j][1]); w.y = pk2(v[j][2], v[j][3]); r[64 * j] = w; }
}
__device__ __forceinline__ void norm_mod(f32x4 (&v)[4], const float* g, const float* scale, const float* shift, int lane) {
    float ss = 0.f;
#pragma unroll
    for (int j = 0; j < 4; ++j) ss += (v[j][0] * v[j][0] + v[j][1] * v[j][1]) + (v[j][2] * v[j][2] + v[j][3] * v[j][3]);
    const float rinv = __builtin_amdgcn_rsqf(wave_sum(ss) * (1.0f / D) + RMS_EPS);
    f32x4 gv[4], sv[4], hv[4]; load_row(g, lane, gv); load_row(scale, lane, sv); load_row(shift, lane, hv);
#pragma unroll
    for (int j = 0; j < 4; ++j) v[j] = v[j] * rinv * gv[j] * (sv[j] + 1.0f) + hv[j];
}
__device__ __forceinline__ void p_norm1(Frame& F, const Args& A, const float* X, int layer) {
    const int gw = blockIdx.x * NWAVES + F.wave, NGW = F.G * NWAVES;
    for (int m = gw; m < NTOK; m += NGW) {
        f32x4 v[4]; load_row(X + (size_t)m * D, F.lane, v);
        const float* md = A_mod + (size_t)(layer * 8 + m / SEQ) * 6144;
        norm_mod(v, A_n1g + layer * D, md + 1024, md, F.lane);
        store_row_bf16(A_H + (size_t)m * D, F.lane, v);
    }
}
constexpr int TP = 2048 + 64;
constexpr int WTILE = 8 * TP;
__device__ __forceinline__ void tile_put(LAS char* tile, int r, int lane, const f32x4 (&v)[4]) {
#pragma unroll
    for (int j = 0; j < 4; ++j) { u32x2 hi, lo; hi.x = pk2(v[j][0], v[j][1]); hi.y = pk2(v[j][2], v[j][3]);
        lo.x = pk2(v[j][0] - bflo(hi.x), v[j][1] - bfhi(hi.x)); lo.y = pk2(v[j][2] - bflo(hi.y), v[j][3] - bfhi(hi.y));
        *(LAS u32x2*)(tile + r * TP + 512 * j + 8 * lane) = hi; *(LAS u32x2*)(tile + (4 + r) * TP + 512 * j + 8 * lane) = lo; }
}
template <int NEB> __device__ __forceinline__ void rows4_proj(const LAS char* tile, const bf16_t* Wt, int lane, f32x4 (&acc)[NEB]) {
    const LAS char* ap = tile + (lane & 3) * TP + (lane >> 4) * 16;
    const bf16_t* bp = Wt + (size_t)(lane & 15) * 1024 + (lane >> 4) * 8;
#pragma unroll
    for (int eb = 0; eb < NEB; ++eb) acc[eb] = (f32x4){0.f, 0.f, 0.f, 0.f};
#pragma unroll 4
    for (int ks = 0; ks < 32; ++ks) {
        const bf16x8 ah = *(const LAS bf16x8*)(ap + ks * 64), al = *(const LAS bf16x8*)(ap + 4 * TP + ks * 64);
#pragma unroll
        for (int eb = 0; eb < NEB; ++eb) { const bf16x8 bh = *(const bf16x8*)(bp + eb * 16 * 1024 + ks * 32), bl = *(const bf16x8*)(bp + (NEB + eb) * 16 * 1024 + ks * 32);
            acc[eb] = __builtin_amdgcn_mfma_f32_16x16x32_bf16(ah, bh, acc[eb], 0, 0, 0);
            acc[eb] = __builtin_amdgcn_mfma_f32_16x16x32_bf16(ah, bl, acc[eb], 0, 0, 0);
            acc[eb] = __builtin_amdgcn_mfma_f32_16x16x32_bf16(al, bh, acc[eb], 0, 0, 0); }
    }
}
__device__ __forceinline__ void p_norm2_route(Frame& F, const Args& A, const float* X, int layer) {
    LAS char* tile = (LAS char*)(F.lds + RING_OFF + F.wave * WTILE);
    LAS int* sel_e = (LAS int*)(F.lds + SEL_OFF); LAS float* sel_w = (LAS float*)(F.lds + SEL_OFF + 2048);
    LAS unsigned* lcnt = (LAS unsigned*)(F.lds + MISC_OFF) + 16; LAS unsigned* lbase = (LAS unsigned*)(F.lds + MISC_OFF) + 48;
    if (F.tid < 32) lcnt[F.tid] = 0u;
    __syncthreads();
    const bf16_t* Wt = A_WTR + (size_t)layer * 2 * 32 * 1024;
    const int le = F.lane & 15;
    const float rb0 = A_r_b[layer * NE + le], rb1 = A_r_b[layer * NE + 16 + le];
    for (int ch = blockIdx.x; ch < NTOK / 128; ch += F.G) {
        const int tokbase = ch * 128;
#pragma unroll 1
        for (int g4 = 0; g4 < 4; ++g4) {
            const int tl = 16 * F.wave + 4 * g4;
#pragma unroll
            for (int r = 0; r < 4; ++r) { const int m = tokbase + tl + r; f32x4 h[4]; load_row(X + (size_t)m * D, F.lane, h);
                const float* md = A_mod + (size_t)(layer * 8 + m / SEQ) * 6144;
                norm_mod(h, A_n2g + layer * D, md + 4 * 1024, md + 3 * 1024, F.lane);
                store_row_bf16(A_H + (size_t)m * D, F.lane, h); tile_put(tile, r, F.lane, h); }
            LDS_WAIT(); asm volatile("" ::: "memory");
            f32x4 acc[2]; rows4_proj<2>(tile, Wt, F.lane, acc);
#pragma unroll
            for (int r = 0; r < 4; ++r) {
                const float va = acc[0][r] + rb0, vb = acc[1][r] + rb1;
                int ca = 0, cb = 0; float mx = __builtin_fmaxf(va, vb);
#pragma unroll 4
                for (int j = 0; j < 16; ++j) { const float la = __builtin_bit_cast(float, __builtin_amdgcn_readlane(__builtin_bit_cast(int, va), j)), lb = __builtin_bit_cast(float, __builtin_amdgcn_readlane(__builtin_bit_cast(int, vb), j));
                    ca += ((la > va || (la == va && j < le)) ? 1 : 0) + ((lb > va) ? 1 : 0);
                    cb += ((la >= vb) ? 1 : 0) + ((lb > vb || (lb == vb && j < le)) ? 1 : 0);
                    mx = __builtin_fmaxf(mx, __builtin_fmaxf(la, lb)); }
                const bool act = F.lane < 16, sa = act && ca < 4, sb = act && cb < 4;
                const float pa = sa ? __expf(va - mx) : 0.f, pb = sb ? __expf(vb - mx) : 0.f; const float sum = wave_sum(pa + pb);
                if (sa) { sel_e[(tl + r) * 4 + ca] = le; sel_w[(tl + r) * 4 + ca] = pa / sum; }
                if (sb) { sel_e[(tl + r) * 4 + cb] = 16 + le; sel_w[(tl + r) * 4 + cb] = pb / sum; }
            }
            LDS_WAIT(); asm volatile("" ::: "memory");
        }
        __syncthreads();
        const int e = sel_e[F.tid]; const float w = sel_w[F.tid];
        const unsigned rank = __hip_atomic_fetch_add(lcnt + e, 1u, __ATOMIC_RELAXED, __HIP_MEMORY_SCOPE_WORKGROUP);
        __syncthreads();
        if (F.tid < 32) { const unsigned n = lcnt[F.tid]; lbase[F.tid] = n ? __hip_atomic_fetch_add((unsigned*)(F.ctl + CW_CNT + (layer * 32 + F.tid) * 64), n, RLX_AGENT) : 0u; lcnt[F.tid] = 0u; }
        __syncthreads();
        const unsigned slot = (unsigned)(tokbase * 4 + F.tid);
        A_TOKLIST[(size_t)e * ECAP + lbase[e] + rank] = slot; A_GATEW[slot] = w;
        __syncthreads();
    }
}
template <bool NEXT> __device__ __forceinline__ void p_combine(Frame& F, const Args& A, const float* Xi, float* Xo, int layer) {
    LAS char* tile = (LAS char*)(F.lds + RING_OFF + F.wave * WTILE);
    const int gw = blockIdx.x * NWAVES + F.wave, NGW = F.G * NWAVES;
    for (int m4 = gw * 4; m4 < NTOK; m4 += NGW * 4) {
#pragma unroll
        for (int r = 0; r < 4; ++r) { const int m = m4 + r;
            f32x4 v[4]; load_row(Xi + (size_t)m * D, F.lane, v);
            const float* md = A_mod + (size_t)(layer * 8 + m / SEQ) * 6144;
            f32x4 g2[4]; load_row(md + 5 * 1024, F.lane, g2);
            f32x4 s[4];
#pragma unroll
            for (int j = 0; j < 4; ++j) s[j] = (f32x4){0.f, 0.f, 0.f, 0.f};
#pragma unroll
            for (int k = 0; k < 4; ++k) { const GAS u32x2* yr = (const GAS u32x2*)(A_Y + (size_t)(m * 4 + k) * D) + F.lane;
#pragma unroll
                for (int j = 0; j < 4; ++j) { const u32x2 w = yr[64 * j]; s[j][0] += bflo(w.x); s[j][1] += bfhi(w.x); s[j][2] += bflo(w.y); s[j][3] += bfhi(w.y); } }
#pragma unroll
            for (int j = 0; j < 4; ++j) v[j] = v[j] + g2[j] * s[j];
            store_row(Xo + (size_t)m * D, F.lane, v);
            if (NEXT) {
                const float* md1 = A_mod + (size_t)((layer + 1) * 8 + m / SEQ) * 6144;
                norm_mod(v, A_n1g + (layer + 1) * D, md1 + 1024, md1, F.lane);
                store_row_bf16(A_H + (size_t)m * D, F.lane, v); tile_put(tile, r, F.lane, v);
            }
            asm volatile("" ::: "memory");
        }
        if (NEXT) {
            LDS_WAIT(); asm volatile("" ::: "memory");
            f32x4 acc[1]; rows4_proj<1>(tile, A_WTA, F.lane, acc);
            if (F.lane < 16) {
#pragma unroll
                for (int r = 0; r < 4; ++r) A_APROJ[(size_t)(m4 + r) * 16 + F.lane] = acc[0][r]; }
            LDS_WAIT(); asm volatile("" ::: "memory");
        }
    }
}

namespace att {
constexpr int NK = 384, KCH = NK * 16 + 16, VH = NK * 64 + 64;
constexpr int K_OFF = 0, V_OFF = 8 * KCH, ST_OFF = V_OFF + 2 * VH, WS_OFF = ST_OFF + 8 * 4096, BYTES = WS_OFF + 8 * 256;
static_assert(RING_OFF + BYTES <= LDS_BYTES, "attention LDS");
template <int GRP> __device__ __forceinline__ void unit(Frame& F, const Args& A, int b, int h, int r, int blk) {
    constexpr int dil = (GRP == 0) ? 1 : (GRP == 1) ? 4 : 16;
    const int tid = F.tid, lane = F.lane, r32 = lane & 31, hi = lane >> 5, w = F.wave;
    const int u0 = blk * 256; const size_t rowb = (size_t)b * SEQ;
    int r32m = r32, tidm = tid, him = hi; asm volatile("" : "+v"(r32m), "+v"(tidm), "+v"(him));
    const bf16_t* Qg = A_QKV + GRP * 3072 + h * 64;
    LAS char* lds = (LAS char*)(F.lds + RING_OFF);
    u32x4 kv[6], vv[6];
#pragma unroll
    for (int i = 0; i < 6; ++i) { const int p = tid + 512 * i, key = p >> 3, c = p & 7, up = u0 - 128 + key;
        if (up >= 0) { const bf16_t* src = Qg + (rowb + (size_t)up * dil + r) * NQKV + c * 8; kv[i] = *(const u32x4*)(src + 1024); vv[i] = *(const u32x4*)(src + 2048); }
        else { kv[i] = (u32x4){0u, 0u, 0u, 0u}; vv[i] = kv[i]; } }
    bf16x8 qr[4];
    { const bf16_t* qp = Qg + (rowb + (size_t)(u0 + 32 * w + r32) * dil + r) * NQKV + hi * 8;
#pragma unroll
      for (int d0 = 0; d0 < 4; ++d0) qr[d0] = *(const bf16x8*)(qp + d0 * 16); }
#pragma unroll
    for (int i = 0; i < 6; ++i) { const int p = tidm + 512 * i, key = p >> 3, c = p & 7;
        *(LAS u32x4*)(lds + K_OFF + c * KCH + key * 16) = kv[i];
        *(LAS u32x4*)(lds + V_OFF + (c >> 2) * VH + key * 64 + (c & 3) * 16) = vv[i]; }
    __syncthreads();
    const int lo = (blk == 0) ? ((4 - w) > 0 ? (4 - w) : 0) : 0;
    f32x16 s[5];
    const float NEG = -INFINITY;
#pragma unroll
    for (int kp = 0; kp < 5; ++kp) {
        f32x16 a;
#pragma unroll
        for (int q = 0; q < 16; ++q) a[q] = (kp >= lo) ? 0.f : NEG;
        if (kp >= lo) {
            const LAS char* kb = lds + K_OFF + hi * KCH + ((w + kp) * 32 + r32) * 16;
#pragma unroll
            for (int d0 = 0; d0 < 4; ++d0) { const bf16x8 kf = *(const LAS bf16x8*)(kb + 2 * d0 * KCH); a = __builtin_amdgcn_mfma_f32_32x32x16_bf16(kf, qr[d0], a, 0, 0, 0); }
            if (kp == 0) {
#pragma unroll
                for (int q = 0; q < 16; ++q) if (crow(q, him) < r32m) a[q] = NEG; }
            if (kp == 4) {
#pragma unroll
                for (int q = 0; q < 16; ++q) if (crow(q, him) > r32m) a[q] = NEG; }
        }
        s[kp] = a;
    }
    float m = NEG;
#pragma unroll
    for (int kp = 0; kp < 5; ++kp)
#pragma unroll
        for (int q = 0; q < 16; ++q) m = __builtin_fmaxf(m, s[kp][q]);
    m = __builtin_fmaxf(m, __shfl_xor(m, 32));
    float l = 0.f;
#pragma unroll
    for (int kp = 0; kp < 5; ++kp)
#pragma unroll
        for (int q = 0; q < 16; ++q) { const float p = __builtin_amdgcn_exp2f(s[kp][q] - m); s[kp][q] = p; l += p; }
    l += __shfl_xor(l, 32);
    f32x16 o[2];
#pragma unroll
    for (int q = 0; q < 16; ++q) { o[0][q] = 0.f; o[1][q] = 0.f; }
    const LAS char* vb = lds + V_OFF + ((lane >> 4) & 1) * 32 + (lane & 3) * 8 + (4 * hi + ((lane & 15) >> 2)) * 64;
#pragma unroll
    for (int kp = 0; kp < 5; ++kp) {
        if (kp >= lo) {
            u32x4 pw0, pw1;
            pw0.x = cvt_pk_bf16(s[kp][0], s[kp][1]); pw0.y = cvt_pk_bf16(s[kp][2], s[kp][3]); pw0.z = cvt_pk_bf16(s[kp][4], s[kp][5]); pw0.w = cvt_pk_bf16(s[kp][6], s[kp][7]);
            pw1.x = cvt_pk_bf16(s[kp][8], s[kp][9]); pw1.y = cvt_pk_bf16(s[kp][10], s[kp][11]); pw1.z = cvt_pk_bf16(s[kp][12], s[kp][13]); pw1.w = cvt_pk_bf16(s[kp][14], s[kp][15]);
            const bf16x8 pa0 = __builtin_bit_cast(bf16x8, pw0), pa1 = __builtin_bit_cast(bf16x8, pw1);
#pragma unroll
            for (int d0 = 0; d0 < 2; ++d0) {
                const LAS char* vp = vb + d0 * VH + ((w + kp) * 32) * 64;
                const s16x4 l0 = tr_read(vp), h0 = tr_read(vp + 512), l1 = tr_read(vp + 1024), h1 = tr_read(vp + 1536);
                o[d0] = __builtin_amdgcn_mfma_f32_32x32x16_bf16(pa0, CAT8(l0, h0), o[d0], 0, 0, 0);
                o[d0] = __builtin_amdgcn_mfma_f32_32x32x16_bf16(pa1, CAT8(l1, h1), o[d0], 0, 0, 0);
            }
        }
    }
    LAS float* wsf = (LAS float*)(lds + WS_OFF + w * 256);
    LAS bf16_t* stg = (LAS bf16_t*)(lds + ST_OFF + w * 4096);
    if (hi == 0) { wsf[r32] = __builtin_amdgcn_rcpf(l); wsf[32 + r32] = m + __builtin_amdgcn_logf(l); }
    LDS_WAIT(); asm volatile("" ::: "memory");
    int hie = hi; asm volatile("" : "+v"(hie));
#pragma unroll
    for (int q = 0; q < 16; ++q) { const int orow = crow(q, hie); const float rl = wsf[orow];
        stg[orow * 64 + r32] = (bf16_t)f2bf(o[0][q] * rl); stg[orow * 64 + 32 + r32] = (bf16_t)f2bf(o[1][q] * rl); }
    LDS_WAIT(); asm volatile("" ::: "memory");
#pragma unroll
    for (int i = 0; i < 4; ++i) {
        const int row = i * 8 + (lane >> 3), ch = lane & 7;
        u32x4 v = *(const LAS u32x4*)(stg + row * 64 + ch * 8);
        const size_t grow = rowb + (size_t)(u0 + 32 * w + row) * dil + r;
        bf16_t* op = A_O + grow * D + h * 64 + ch * 8; float* lp = A_LSE + grow * 16 + h;
        float ln = wsf[32 + row];
        if (GRP > 0) {
            const u32x4 old = *(const u32x4*)op; const float lold = *lp;
            const float mx = __builtin_fmaxf(lold, ln), L = mx + __builtin_amdgcn_logf(__builtin_amdgcn_exp2f(lold - mx) + __builtin_amdgcn_exp2f(ln - mx));
            const float wo = __builtin_amdgcn_exp2f(lold - L), wn = __builtin_amdgcn_exp2f(ln - L);
            v.x = cvt_pk_bf16(bflo(old.x) * wo + bflo(v.x) * wn, bfhi(old.x) * wo + bfhi(v.x) * wn);
            v.y = cvt_pk_bf16(bflo(old.y) * wo + bflo(v.y) * wn, bfhi(old.y) * wo + bfhi(v.y) * wn);
            v.z = cvt_pk_bf16(bflo(old.z) * wo + bflo(v.z) * wn, bfhi(old.z) * wo + bfhi(v.z) * wn);
            v.w = cvt_pk_bf16(bflo(old.w) * wo + bflo(v.w) * wn, bfhi(old.w) * wo + bfhi(v.w) * wn);
            ln = L;
        }
        *(u32x4*)op = v; if (ch == 0) *lp = ln;
    }
    __syncthreads();
}
template <int GRP> __device__ __forceinline__ void phase(Frame& F, const Args& A) {
    constexpr int dil = (GRP == 0) ? 1 : (GRP == 1) ? 4 : 16;
    for (int id = blockIdx.x; id < NB * 16 * 16; id += F.G) { const int bh = id >> 4, wi = id & 15; unit<GRP>(F, A, bh >> 4, bh & 15, wi % dil, wi / dil); }
}
}

namespace gla {
constexpr int QCH = 64 * 16 + 16;
constexpr int TH = 64 * 64 + 64;
constexpr int QD_OFF = 0, KI_OFF = 16 * QCH, KD_OFF = 32 * QCH, V_OFF = KD_OFF + 4 * TH, OST_OFF = V_OFF + 8 * TH, OSTP = 528;
constexpr int A_OFF = OST_OFF + 64 * OSTP, SEG_OFF = A_OFF + 4096, DEC_OFF = SEG_OFF + 2048, WG_OFF = DEC_OFF + 512, BYTES = WG_OFF + 16 * 128 * 4;
static_assert(RING_OFF + BYTES <= LDS_BYTES, "gla LDS");
__device__ __forceinline__ int swap23(int d) { return (d & ~12) | ((d & 4) << 1) | ((d & 8) >> 1); }
__device__ __forceinline__ void phase(Frame& F, const Args& A) {
    if ((int)blockIdx.x >= NB * 4) return;
    const int b = blockIdx.x >> 2, hd = blockIdx.x & 3;
    const int lane = F.lane, r32 = lane & 31, hi = lane >> 5, w = F.wave;
    LAS char* lds = (LAS char*)(F.lds + RING_OFF);
    const int d = F.tid & 127, seg = F.tid >> 7;
    if (seg == 0) {
#pragma unroll
        for (int j = 0; j < 16; ++j) ((LAS float*)(lds + WG_OFF))[j * 128 + d] = A_b_wg[j * 512 + hd * 128 + d]; }
    const float gbias = A_b_gb[hd * 128 + d];
    f32x16 S[4];
#pragma unroll
    for (int k = 0; k < 4; ++k)
#pragma unroll
        for (int q = 0; q < 16; ++q) S[k][q] = 0.f;
    const LAS char* trb = lds + ((lane >> 4) & 1) * 32 + (lane & 3) * 8 + (4 * hi + ((lane & 15) >> 2)) * 64;
#pragma unroll 1
    for (int n = 0; n < SEQ / 64; ++n) {
        const size_t row0 = (size_t)b * SEQ + n * 64;
        int tid = F.tid; asm volatile("" : "+v"(tid));
        const int d = tid & 127, seg = tid >> 7, c_n = tid >> 3, sg_n = tid & 7;
        const int dsw = swap23(d);
        const int qwoff = (dsw >> 3) * QCH + (dsw & 7) * 2;
        const int kdoff = KD_OFF + (d >> 5) * TH + (d & 31) * 2;
        if (tid < 256) *(LAS f32x4*)(lds + A_OFF + tid * 16) = *(const f32x4*)(A_APROJ + row0 * 16 + tid * 4);
#pragma unroll
        for (int i = 0; i < 4; ++i) { const int p = tid + 512 * i, c = p >> 5, ch = p & 31;
            const u32x4 v = *(const u32x4*)(A_PROJ + (row0 + c) * NPROJ + 1024 + hd * 256 + ch * 8);
            *(LAS u32x4*)(lds + V_OFF + (ch >> 2) * TH + c * 64 + (ch & 3) * 16) = v; }
        unsigned qk[16];
#pragma unroll
        for (int i = 0; i < 16; ++i) { const bf16_t* pr = A_PROJ + (row0 + 16 * seg + i) * NPROJ + hd * 128 + d; qk[i] = (unsigned)pr[0] | ((unsigned)pr[512] << 16); }
        __syncthreads();
        float cs[16]; float run = 0.f;
#pragma unroll
        for (int i = 0; i < 16; ++i) { const LAS f32x4* ap = (const LAS f32x4*)(lds + A_OFF + (16 * seg + i) * 64); float z = gbias;
#pragma unroll
            for (int j4 = 0; j4 < 4; ++j4) { const f32x4 a = ap[j4]; const LAS float* wgp = (const LAS float*)(lds + WG_OFF) + d;
                z += a[0] * wgp[(4 * j4) * 128] + a[1] * wgp[(4 * j4 + 1) * 128] + a[2] * wgp[(4 * j4 + 2) * 128] + a[3] * wgp[(4 * j4 + 3) * 128]; }
            const float sp = __builtin_fmaxf(-z, 0.f) + __logf(1.0f + __expf(-__builtin_fabsf(z)));
            run -= sp * (LOG2E / 16.0f); cs[i] = run; }
        ((LAS float*)(lds + SEG_OFF))[seg * 128 + d] = run;
        __syncthreads();
        float pre = 0.f, tot = 0.f;
#pragma unroll
        for (int s2 = 0; s2 < 4; ++s2) { const float t = ((const LAS float*)(lds + SEG_OFF))[s2 * 128 + d]; if (s2 < seg) pre += t; tot += t; }
        if (seg == 0) ((LAS float*)(lds + DEC_OFF))[d] = __builtin_amdgcn_exp2f(tot);
#pragma unroll
        for (int i = 0; i < 16; ++i) { const int c = 16 * seg + i; const float bb = pre + cs[i];
            const float eb = __builtin_amdgcn_exp2f(bb), enb = __builtin_amdgcn_exp2f(-bb), elb = __builtin_amdgcn_exp2f(tot - bb);
            const float qf = bflo(qk[i]), kf = bfhi(qk[i]);
            *(LAS bf16_t*)(lds + QD_OFF + qwoff + c * 16) = (bf16_t)f2bf(qf * 0.08838834764831845f * eb);
            *(LAS bf16_t*)(lds + KI_OFF + qwoff + c * 16) = (bf16_t)f2bf(kf * enb);
            *(LAS bf16_t*)(lds + kdoff + c * 64) = (bf16_t)f2bf(kf * elb); }
        __syncthreads();
        f32x16 o[2];
#pragma unroll
        for (int q = 0; q < 16; ++q) { o[0][q] = 0.f; o[1][q] = 0.f; }
        const LAS char* vtr = trb + V_OFF + w * TH;
#define GLA_PK(A, B) __builtin_bit_cast(bf16x8, (u32x4){cvt_pk_bf16(A[B], A[B + 1]), cvt_pk_bf16(A[B + 2], A[B + 3]), cvt_pk_bf16(A[B + 4], A[B + 5]), cvt_pk_bf16(A[B + 6], A[B + 7])})
        const LAS char* kp = lds + KI_OFF + hi * QCH + r32 * 16; const LAS char* qp = lds + QD_OFF + hi * QCH + r32 * 16;
        bf16x8 v0, v1, v2, v3;
        {
            { const s16x4 l0 = tr_read(vtr), h0 = tr_read(vtr + 512), l1 = tr_read(vtr + 1024), h1 = tr_read(vtr + 1536); v0 = CAT8(l0, h0); v1 = CAT8(l1, h1); }
            { f32x16 a00;
#pragma unroll
              for (int q = 0; q < 16; ++q) a00[q] = 0.f;
#pragma unroll
              for (int ks = 0; ks < 8; ++ks) a00 = __builtin_amdgcn_mfma_f32_32x32x16_bf16(*(const LAS bf16x8*)(kp + 2 * ks * QCH), *(const LAS bf16x8*)(qp + 2 * ks * QCH), a00, 0, 0, 0);
#pragma unroll
              for (int q = 0; q < 16; ++q) if (crow(q, hi) > r32) a00[q] = 0.f;
              o[0] = __builtin_amdgcn_mfma_f32_32x32x16_bf16(GLA_PK(a00, 0), v0, o[0], 0, 0, 0);
              o[0] = __builtin_amdgcn_mfma_f32_32x32x16_bf16(GLA_PK(a00, 8), v1, o[0], 0, 0, 0); }
            __builtin_amdgcn_sched_barrier(0);
            { f32x16 a01;
#pragma unroll
              for (int q = 0; q < 16; ++q) a01[q] = 0.f;
#pragma unroll
              for (int ks = 0; ks < 8; ++ks) a01 = __builtin_amdgcn_mfma_f32_32x32x16_bf16(*(const LAS bf16x8*)(kp + 2 * ks * QCH), *(const LAS bf16x8*)(qp + 2 * ks * QCH + 512), a01, 0, 0, 0);
              o[1] = __builtin_amdgcn_mfma_f32_32x32x16_bf16(GLA_PK(a01, 0), v0, o[1], 0, 0, 0);
              o[1] = __builtin_amdgcn_mfma_f32_32x32x16_bf16(GLA_PK(a01, 8), v1, o[1], 0, 0, 0); }
            __builtin_amdgcn_sched_barrier(0);
            { const s16x4 l2 = tr_read(vtr + 2048), h2 = tr_read(vtr + 2560), l3 = tr_read(vtr + 3072), h3 = tr_read(vtr + 3584); v2 = CAT8(l2, h2); v3 = CAT8(l3, h3); }
            { f32x16 a11;
#pragma unroll
              for (int q = 0; q < 16; ++q) a11[q] = 0.f;
#pragma unroll
              for (int ks = 0; ks < 8; ++ks) a11 = __builtin_amdgcn_mfma_f32_32x32x16_bf16(*(const LAS bf16x8*)(kp + 2 * ks * QCH + 512), *(const LAS bf16x8*)(qp + 2 * ks * QCH + 512), a11, 0, 0, 0);
#pragma unroll
              for (int q = 0; q < 16; ++q) if (crow(q, hi) > r32) a11[q] = 0.f;
              o[1] = __builtin_amdgcn_mfma_f32_32x32x16_bf16(GLA_PK(a11, 0), v2, o[1], 0, 0, 0);
              o[1] = __builtin_amdgcn_mfma_f32_32x32x16_bf16(GLA_PK(a11, 8), v3, o[1], 0, 0, 0); }
            __builtin_amdgcn_sched_barrier(0);
#pragma unroll
            for (int k = 0; k < 4; ++k)
#pragma unroll
                for (int s2 = 0; s2 < 2; ++s2) { const bf16x8 sb = GLA_PK(S[k], 8 * s2);
                    const bf16x8 q0 = *(const LAS bf16x8*)(qp + (4 * k + 2 * s2) * QCH), q1 = *(const LAS bf16x8*)(qp + (4 * k + 2 * s2) * QCH + 512);
                    o[0] = __builtin_amdgcn_mfma_f32_32x32x16_bf16(q0, sb, o[0], 0, 0, 0);
                    o[1] = __builtin_amdgcn_mfma_f32_32x32x16_bf16(q1, sb, o[1], 0, 0, 0); }
#pragma unroll
            for (int k = 0; k < 4; ++k) {
#pragma unroll
                for (int q4 = 0; q4 < 4; ++q4) { const f32x4 dc = *(const LAS f32x4*)(lds + DEC_OFF + (32 * k + 8 * q4 + 4 * hi) * 4);
                    S[k][4 * q4] *= dc[0]; S[k][4 * q4 + 1] *= dc[1]; S[k][4 * q4 + 2] *= dc[2]; S[k][4 * q4 + 3] *= dc[3]; }
                const LAS char* ktr = trb + KD_OFF + k * TH;
                const s16x4 kl0 = tr_read(ktr), kh0 = tr_read(ktr + 512), kl1 = tr_read(ktr + 1024), kh1 = tr_read(ktr + 1536);
                const s16x4 kl2 = tr_read(ktr + 2048), kh2 = tr_read(ktr + 2560), kl3 = tr_read(ktr + 3072), kh3 = tr_read(ktr + 3584);
                S[k] = __builtin_amdgcn_mfma_f32_32x32x16_bf16(CAT8(kl0, kh0), v0, S[k], 0, 0, 0);
                S[k] = __builtin_amdgcn_mfma_f32_32x32x16_bf16(CAT8(kl1, kh1), v1, S[k], 0, 0, 0);
                S[k] = __builtin_amdgcn_mfma_f32_32x32x16_bf16(CAT8(kl2, kh2), v2, S[k], 0, 0, 0);
                S[k] = __builtin_amdgcn_mfma_f32_32x32x16_bf16(CAT8(kl3, kh3), v3, S[k], 0, 0, 0);
            }
        }
#undef GLA_PK
#pragma unroll
        for (int cb = 0; cb < 2; ++cb)
#pragma unroll
            for (int q = 0; q < 16; ++q) *(LAS bf16_t*)(lds + OST_OFF + (32 * cb + crow(q, hi)) * OSTP + (32 * w + r32) * 2) = (bf16_t)f2bf(o[cb][q]);
        __syncthreads();
        { u32x4 ov[4]; float ss = 0.f;
#pragma unroll
          for (int i = 0; i < 4; ++i) { ov[i] = *(const LAS u32x4*)(lds + OST_OFF + c_n * OSTP + sg_n * 64 + i * 16);
              const float a0 = bflo(ov[i].x), a1 = bfhi(ov[i].x), a2 = bflo(ov[i].y), a3 = bfhi(ov[i].y), a4 = bflo(ov[i].z), a5 = bfhi(ov[i].z), a6 = bflo(ov[i].w), a7 = bfhi(ov[i].w);
              ss += (a0 * a0 + a1 * a1) + (a2 * a2 + a3 * a3) + (a4 * a4 + a5 * a5) + (a6 * a6 + a7 * a7); }
          ss += __shfl_xor(ss, 1); ss += __shfl_xor(ss, 2); ss += __shfl_xor(ss, 4);
          const float rinv = __builtin_amdgcn_rsqf(ss * (1.0f / 256.0f) + RMS_EPS);
          const bf16_t* rp = A_PROJ + (row0 + c_n) * NPROJ + 2048 + hd * 256 + 32 * sg_n;
          bf16_t* op = A_O + (row0 + c_n) * D + hd * 256 + 32 * sg_n;
#pragma unroll
          for (int i = 0; i < 4; ++i) { const u32x4 rv = *(const u32x4*)(rp + 8 * i); u32x4 res; float og[8];
              { const f32x4 g0 = *(const f32x4*)(A_b_og + 32 * sg_n + 8 * i), g1 = *(const f32x4*)(A_b_og + 32 * sg_n + 8 * i + 4); og[0] = g0[0]; og[1] = g0[1]; og[2] = g0[2]; og[3] = g0[3]; og[4] = g1[0]; og[5] = g1[1]; og[6] = g1[2]; og[7] = g1[3]; }
              const unsigned ow[4] = {ov[i].x, ov[i].y, ov[i].z, ov[i].w}, rw[4] = {rv.x, rv.y, rv.z, rv.w}; unsigned out[4];
#pragma unroll
              for (int j = 0; j < 4; ++j) { const float r0 = bflo(rw[j]), r1 = bfhi(rw[j]);
                  const float s0 = r0 * __builtin_amdgcn_rcpf(1.0f + __builtin_amdgcn_exp2f(-LOG2E * r0)), s1 = r1 * __builtin_amdgcn_rcpf(1.0f + __builtin_amdgcn_exp2f(-LOG2E * r1));
                  out[j] = cvt_pk_bf16(bflo(ow[j]) * rinv * og[2 * j] * s0, bfhi(ow[j]) * rinv * og[2 * j + 1] * s1); }
              res.x = out[0]; res.y = out[1]; res.z = out[2]; res.w = out[3];
              *(u32x4*)(op + 8 * i) = res; } }
        __syncthreads();
    }
}
}

__device__ __forceinline__ int moe_build_units(Frame& F, const Args& A, int layer, int npn) {
    LAS int* tstart = (LAS int*)(F.lds + MISC_OFF) + 80; LAS int* ecnt = (LAS int*)(F.lds + MISC_OFF) + 128; LAS int* ulist = (LAS int*)(F.lds + SEL_OFF);
    if (F.tid < 32) ecnt[F.tid] = (int)__hip_atomic_load((unsigned*)(F.ctl + CW_CNT + (layer * 32 + F.tid) * 64), RLX_AGENT);
    __syncthreads();
    if (F.tid == 0) { int s = 0; for (int e = 0; e < 32; ++e) { tstart[e] = s; s += (ecnt[e] + 255) >> 8; } tstart[32] = s; }
    __syncthreads();
    const int utot = tstart[32] * npn;
    int lo, hi, step, first;
    if (F.G % 8 == 0) { const int x = blockIdx.x % 8; lo = (int)(((long)utot * x) / 8); hi = (int)(((long)utot * (x + 1)) / 8); step = F.G / 8; first = blockIdx.x / 8; }
    else { lo = 0; hi = utot; step = F.G; first = blockIdx.x; }
    const int span = hi - lo - first; const int n = span > 0 ? (span + step - 1) / step : 0;
    if (F.tid < n && F.tid < 1024) {
        const int L = lo + first + step * F.tid, T = L / npn, pn = L % npn;
        int e = 0;
#pragma unroll
        for (int bit = 16; bit >= 1; bit >>= 1) if (e + bit < 32 && tstart[e + bit] <= T) e += bit;
        ulist[F.tid] = e | ((T - tstart[e]) << 8) | (pn << 20);
    }
    __syncthreads();
    return n < 512 ? n : 512;
}

enum Phase { P_PRO = 0, P_N1, P_QKV, P_ATT0, P_ATT1, P_ATT2, P_AOUT, P_R0, P_GU0, P_DN0, P_C0, P_BIN, P_GLA, P_BOUT, P_R1, P_GU1, P_DN1, P_C1, P_COUNT };

__global__ void __launch_bounds__(NWAVES * 64, 2) mk_fwd(Args args) {
    extern __shared__ __attribute__((aligned(16))) unsigned char lds_raw[];
    Frame F;
    F.lds = (LAS unsigned char*)lds_raw;
    F.MISC = (volatile LAS unsigned*)(F.lds + MISC_OFF);
    F.tid = threadIdx.x; F.lane = F.tid & 63; F.wave = __builtin_amdgcn_readfirstlane(F.tid >> 6); F.G = gridDim.x;
    const Args& A = args;
    F.ctl = (gu32*)(A.ws + WS_CTL);
    for (int u = F.tid; u < RING_OFF / 4; u += NWAVES * 64) ((LAS unsigned*)F.lds)[u] = 0u;
    __syncthreads();
    XcdBarrier bar; bar.bar = (unsigned*)(F.ctl + CW_BAR); bar.x = 0; bar.st = nullptr;
    if (!MK_PER_PHASE) bar = xcd_barrier_post((unsigned*)(F.ctl + CW_BAR), F.MISC + 8);
    const int lo = args.ph_lo, hi = args.ph_hi;
#ifndef ONLY_PHASE
#define ONLY_PHASE -1
#endif
#define IN(k) ((ONLY_PHASE < 0 || ONLY_PHASE == (k)) && lo <= (k) && (k) < hi && (k) <= MK_LAST_PHASE)
#define SEAM(k) do { if (!MK_PER_PHASE && (k) + 1 < hi) xcd_barrier(bar); } while (0)
    LAS unsigned char* ring = F.lds + RING_OFF; LAS unsigned* tab = (LAS unsigned*)(F.lds + TAB_OFF);
    float* const XB = A_out;

    if (IN(P_PRO)) { p0_prologue(F, A); SEAM(P_PRO); }
    if (IN(P_N1)) { p_norm1(F, A, A_x, 0); SEAM(P_N1); }
    if (IN(P_QKV)) {
        pg8::DenseSched S; S.init(A_H, A_WAIN, NTOK, NQKV, F.G, (int)blockIdx.x);
        pg8::EpiQKV E{A_QKV, A_pos, A_a_qg, A_a_kg};
        pg8::gemm_phase(ring, tab, S, E); SEAM(P_QKV);
    }
    if (IN(P_ATT0) && (MK_PROBE == 0 || MK_PROBE == 5 || MK_PROBE == 6)) { att::phase<0>(F, A); SEAM(P_ATT0); }
    if (IN(P_ATT1) && (MK_PROBE == 0 || MK_PROBE == 6)) { att::phase<1>(F, A); SEAM(P_ATT1); }
    if (IN(P_ATT2) && (MK_PROBE == 0)) { att::phase<2>(F, A); SEAM(P_ATT2); }
    if (IN(P_AOUT)) {
        pg8::DenseSched S;
        if (MK_PROBE == 1) S.init(A_H, A_WAOUT, NTOK, D, F.G, (int)blockIdx.x);
        else if (MK_PROBE == 2) S.init(A_QKV + 2048, A_WAOUT, NTOK, D, F.G, (int)blockIdx.x, NQKV);
        else if (MK_PROBE == 3) S.init(A_QKV, A_WAOUT, NTOK, D, F.G, (int)blockIdx.x, NQKV);
        else if (MK_PROBE == 4) S.init(A_QKV + 1024, A_WAOUT, NTOK, D, F.G, (int)blockIdx.x, NQKV);
        else S.init(A_O, A_WAOUT, NTOK, D, F.G, (int)blockIdx.x);
        pg8::EpiResid E{A_x, A_XA, A_mod + 2 * 1024};
        pg8::gemm_phase(ring, tab, S, E); SEAM(P_AOUT);
    }
#define MOE_LAYER(L, PR, PGU, PDN, XIN) \
    if (IN(PR)) { p_norm2_route(F, A, XIN, L); SEAM(PR); } \
    if (IN(PGU)) { const int n = moe_build_units(F, A, L, 8); \
        pg8::MoeSched<true> S{(const LAS int*)(F.lds + SEL_OFF), n, (const LAS int*)(F.lds + MISC_OFF) + 80, (const LAS int*)(F.lds + MISC_OFF) + 128, A_H, A_WGU + (size_t)(L) * 32 * 2048 * 1024, (size_t)2048 * 1024 * 2, A_TOKLIST}; \
        pg8::EpiGLU E{A_ACT, A_b_gu + (size_t)(L) * 32 * 2048, (const LAS int*)(F.lds + MISC_OFF) + 80}; \
        pg8::gemm_phase(ring, tab, S, E); SEAM(PGU); } \
    if (IN(PDN)) { const int n = moe_build_units(F, A, L, 4); \
        pg8::MoeSched<false> S{(const LAS int*)(F.lds + SEL_OFF), n, (const LAS int*)(F.lds + MISC_OFF) + 80, (const LAS int*)(F.lds + MISC_OFF) + 128, A_ACT, A_WDN + (size_t)(L) * 32 * 1024 * 1024, (size_t)1024 * 1024 * 2, A_TOKLIST}; \
        pg8::EpiDown E{A_Y, A_b_dn + (size_t)(L) * 32 * 1024, A_GATEW}; \
        pg8::gemm_phase(ring, tab, S, E); SEAM(PDN); }
    MOE_LAYER(0, P_R0, P_GU0, P_DN0, A_XA)
    if (IN(P_C0)) { p_combine<true>(F, A, A_XA, XB, 0); SEAM(P_C0); }
    if (IN(P_BIN)) {
        pg8::DenseSched S; S.init(A_H, A_WBIN, NTOK, NPROJ, F.G, (int)blockIdx.x);
        pg8::EpiBf16Plain E{A_PROJ, NPROJ};
        pg8::gemm_phase(ring, tab, S, E); SEAM(P_BIN);
    }
    if (IN(P_GLA)) { gla::phase(F, A); SEAM(P_GLA); }
    if (IN(P_BOUT)) {
        pg8::DenseSched S; S.init(A_O, A_WBOUT, NTOK, D, F.G, (int)blockIdx.x);
        pg8::EpiResid E{XB, A_XA, A_mod + 8 * 6144 + 2 * 1024};
        pg8::gemm_phase(ring, tab, S, E); SEAM(P_BOUT);
    }
    MOE_LAYER(1, P_R1, P_GU1, P_DN1, A_XA)
    if (IN(P_C1)) { p_combine<false>(F, A, A_XA, A_out, 1); }
#if MK_LAST_PHASE < 99
    if (hi == P_COUNT) {
        if (!MK_PER_PHASE) xcd_barrier(bar);
        const float* src = (MK_LAST_PHASE < P_AOUT) ? A_x : (MK_LAST_PHASE < P_C0) ? A_XA : (MK_LAST_PHASE < P_BOUT) ? (const float*)nullptr : A_XA;
        if (src) for (size_t i = (size_t)blockIdx.x * 512 + F.tid; i < (size_t)NTOK * D / 4; i += (size_t)F.G * 512) ((f32x4*)A_out)[i] = ((const f32x4*)src)[i];
    }
#endif
#undef IN
#undef SEAM
}

extern "C" void kernel_launch(void* const* d_in, const int* in_sizes, int n_in, void* d_out, int out_size, void* d_ws, size_t ws_size, hipStream_t stream) {
    static int grid = 0;
    if (grid == 0) {
        if (n_in != 22 || out_size != NTOK * D || ws_size < WS_END) { fprintf(stderr, "kernel_launch: unexpected shapes (n_in %d, out %d, ws %zu < %zu)\n", n_in, out_size, ws_size, (size_t)WS_END); grid = -1; return; }
        int dev = 0, cus = 0, per_cu = 0;
        if (hipGetDevice(&dev) != hipSuccess || hipDeviceGetAttribute(&cus, hipDeviceAttributeMultiprocessorCount, dev) != hipSuccess) { grid = -1; return; }
        if (hipFuncSetAttribute((const void*)mk_fwd, hipFuncAttributeMaxDynamicSharedMemorySize, LDS_BYTES) != hipSuccess) { fprintf(stderr, "kernel_launch: hipFuncSetAttribute failed\n"); grid = -1; return; }
        if (hipOccupancyMaxActiveBlocksPerMultiprocessor(&per_cu, (const void*)mk_fwd, NWAVES * 64, LDS_BYTES) != hipSuccess || per_cu < 1) { fprintf(stderr, "kernel_launch: occupancy query says %d\n", per_cu); }
        (void)hipGetLastError();
        grid = cus;
    }
    if (grid < 0) return;
    if (hipMemsetAsync((char*)d_ws + WS_CTL, 0, CTL_ZERO_BYTES, stream) != hipSuccess) return;
    Args a{};
    for (int i = 0; i < 22; ++i) a.in[i] = d_in[i];
    a.out = (float*)d_out; a.ws = (unsigned char*)d_ws;
#if MK_PER_PHASE
    for (int p = 0; p < P_COUNT; ++p) { a.ph_lo = p; a.ph_hi = p + 1; hipLaunchKernelGGL(mk_fwd, dim3(grid), dim3(NWAVES * 64), LDS_BYTES, stream, a); }
#else
    a.ph_lo = 0; a.ph_hi = P_COUNT;
    hipLaunchKernelGGL(mk_fwd, dim3(grid), dim3(NWAVES * 64), LDS_BYTES, stream, a);
#endif
    const hipError_t le = hipPeekAtLastError();
    if (le != hipSuccess) fprintf(stderr, "kernel_launch: launch failed: %s\n", hipGetErrorName(le));
}
```

```cpp
#include <hip/hip_runtime.h>
#include <cstdio>
#include <cstdint>

#define LAS __attribute__((address_space(3)))
#define GAS __attribute__((address_space(1)))
typedef unsigned short bf16_t;
typedef short bf16x8 __attribute__((ext_vector_type(8)));
typedef short s16x4 __attribute__((ext_vector_type(4)));
typedef float f32x2 __attribute__((ext_vector_type(2)));
typedef float f32x4 __attribute__((ext_vector_type(4)));
typedef float f32x16 __attribute__((ext_vector_type(16)));
typedef unsigned u32x2 __attribute__((ext_vector_type(2)));
typedef unsigned u32x4 __attribute__((ext_vector_type(4)));
typedef GAS unsigned gu32;

#ifndef MK_PER_PHASE
#define MK_PER_PHASE 0
#endif
#ifndef MK_CHECK
#define MK_CHECK 0
#endif
#ifndef MK_CHECK_GAIN
#define MK_CHECK_GAIN 10.0f
#endif
#ifndef MK_PROBE
#define MK_PROBE 0
#endif
#ifndef MK_LAST_PHASE
#define MK_LAST_PHASE 99
#endif

constexpr int D = 1024, NB = 8, SEQ = 4096, NTOK = NB * SEQ;
constexpr int NQKV = 9216, NPROJ = 3072, BIN_PITCH = 3088;
constexpr int NE = 32, TOPK = 4, NASSIGN = NTOK * TOPK, ECAP = NTOK;
constexpr int ACT_ROWS = NASSIGN + NE * 256;
constexpr float RMS_EPS = 1e-6f;
constexpr float LOG2E = 1.4426950408889634f;

constexpr size_t MiB = 1u << 20;
constexpr size_t WS_CTL = 0, CTL_ZERO_BYTES = 1 * MiB;
constexpr size_t WS_MOD = 1 * MiB;
constexpr size_t WS_WAIN = 2 * MiB;
constexpr size_t WS_WAOUT = 20 * MiB;
constexpr size_t WS_WBIN = 22 * MiB;
constexpr size_t WS_WBOUT = 28 * MiB;
constexpr size_t WS_WTR = 30 * MiB;
constexpr size_t WS_WTA = 30 * MiB + 512 * 1024;
constexpr size_t WS_WGU = 32 * MiB;
constexpr size_t WS_WDN = 288 * MiB;
constexpr size_t WS_H = 416 * MiB;
constexpr size_t WS_O = 480 * MiB;
constexpr size_t WS_LSE = 544 * MiB;
constexpr size_t WS_APROJ = 546 * MiB;
constexpr size_t WS_GATEW = 548 * MiB;
constexpr size_t WS_TOKLIST = 549 * MiB;
constexpr size_t WS_XA = 556 * MiB;
constexpr size_t WS_R = 684 * MiB;
constexpr size_t WS_ACT = WS_R;
constexpr size_t WS_Y = WS_R + 272 * MiB;
constexpr size_t WS_END = WS_R + 576 * MiB;
constexpr size_t WS_DBG = WS_END;
static_assert((size_t)ACT_ROWS * 2048 <= 272 * MiB && (size_t)NASSIGN * 2048 <= 304 * MiB, "ws map");
constexpr int CW_TMO = 0, CW_CODE = 1, CW_DBG = 64, CW_BAR = 4096, CW_CNT = 8192;

constexpr int MISC_OFF = 0;
constexpr int TAB_OFF = 1024;
constexpr int SEL_OFF = 4096;
constexpr int RING_OFF = 8192;
constexpr int LDS_BYTES = 147456;

#define RLX_AGENT __ATOMIC_RELAXED, __HIP_MEMORY_SCOPE_AGENT
#define LDS_WAIT() asm volatile("s_waitcnt lgkmcnt(0)" ::: "memory")
#define VM_WAIT() asm volatile("s_waitcnt vmcnt(0)" ::: "memory")
__device__ __forceinline__ unsigned f2bf(float f) { unsigned u = __builtin_bit_cast(unsigned, f); return (u + 0x7fffu + ((u >> 16) & 1u)) >> 16; }
__device__ __forceinline__ unsigned pk2(float lo, float hi) { return f2bf(lo) | (f2bf(hi) << 16); }
typedef __bf16 bf16x2_t __attribute__((ext_vector_type(2)));
__device__ __forceinline__ unsigned cvt_pk_bf16(float lo, float hi) { const f32x2 v = {lo, hi}; const bf16x2_t b = __builtin_convertvector(v, bf16x2_t); return __builtin_bit_cast(unsigned, b); }
__device__ __forceinline__ float bflo(unsigned w) { return __builtin_bit_cast(float, w << 16); }
__device__ __forceinline__ float bfhi(unsigned w) { return __builtin_bit_cast(float, w & 0xffff0000u); }
__device__ __forceinline__ float wave_sum(float v) {
#pragma unroll
    for (int o = 1; o < 64; o <<= 1) v += __shfl_xor(v, o);
    return v;
}
__device__ __forceinline__ int crow(int r, int hi) { return (r & 3) + 8 * (r >> 2) + 4 * hi; }
__device__ __forceinline__ s16x4 tr_read(LAS const char* p) { typedef short v4i16_t __attribute__((ext_vector_type(4))); return __builtin_bit_cast(s16x4, __builtin_amdgcn_ds_read_tr16_b64_v4i16((LAS v4i16_t*)p)); }
#define CAT8(lo, hi) ((bf16x8){lo[0], lo[1], lo[2], lo[3], hi[0], hi[1], hi[2], hi[3]})

namespace pg8 {
constexpr int BM = 256, BK = 64, HALF = 128, HTB = HALF * BK * 2, STAGE_BYTES = 8 * HTB, KD = 1024, NT = KD / BK;
__host__ __device__ __forceinline__ int lds_byte(int r, int c) { const int st = (r >> 4) * 2 + (c >> 5), rr = r & 15, cc = c & 31, ob = rr * 64 + cc * 2; return st * 1024 + (ob ^ (((ob >> 9) & 1) << 5)); }
__host__ __device__ __forceinline__ void stage_rc(int b, int& R, int& C) { const int st = b / 1024, sb = b % 1024, swz = sb ^ (((sb >> 9) & 1) << 5); R = (st >> 1) * 16 + swz / 64; C = (st & 1) * 32 + (swz % 64) / 2; }

struct GUnit { int e, pm, pn, rows; };
typedef f32x4 Acc[2][2][4][2];

template <class Epi, class Sched>
__device__ __forceinline__ void gemm_phase(LAS unsigned char* lds, LAS unsigned* tab, const Sched& S, const Epi& E) {
    const int tid = threadIdx.x, wid = __builtin_amdgcn_readfirstlane(tid >> 6), lane = tid & 63, wr = wid >> 2, wc = wid & 3, fr = lane & 15, fq = lane >> 4;
    int sR[2], sC[2]; unsigned voffB[2];
#pragma unroll
    for (int i = 0; i < 2; ++i) { stage_rc(tid * 16 + i * 8192, sR[i], sC[i]); voffB[i] = (unsigned)(sR[i] * KD + sC[i]) * 2u; }
    constexpr unsigned kstep = BK * 2;
    constexpr size_t hstepB = (size_t)HALF * KD * 2;
    const unsigned ldsw = (unsigned)wid * 1024u;
    const int aoff = lds_byte(wr * 64 + fr, fq * 8), boff = lds_byte(wc * 32 + fr, fq * 8);
    const char* const Ab = S.abase();
#define PG8_SA(b, h) (((b) * 2 + (h)) * HTB)
#define PG8_SB(b, h) ((4 + (b) * 2 + (h)) * HTB)
#define PG8_STAGE_B(bufoff, gbase) do { _Pragma("unroll") for (int _i = 0; _i < 2; ++_i) \
        __builtin_amdgcn_global_load_lds((const unsigned*)((const char*)(gbase) + voffB[_i]), (LAS unsigned*)(lds + (bufoff) + ldsw + _i * 8192), 16, 0, 0); } while (0)
#define PG8_STAGE_A(bufoff, uah, koff) do { _Pragma("unroll") for (int _i = 0; _i < 2; ++_i) \
        __builtin_amdgcn_global_load_lds((const unsigned*)(Ab + (size_t)((uah)[_i]) + (size_t)(koff)), (LAS unsigned*)(lds + (bufoff) + ldsw + _i * 8192), 16, 0, 0); } while (0)
#define PG8_LDA(dst, b, h) do { _Pragma("unroll") for (int m = 0; m < 4; ++m) _Pragma("unroll") for (int k = 0; k < 2; ++k) dst[m][k] = *(const LAS bf16x8*)(lds + PG8_SA(b, h) + aoff + m * 2048 + k * 1024); } while (0)
#define PG8_LDB(dst, b, h) do { _Pragma("unroll") for (int n = 0; n < 2; ++n) _Pragma("unroll") for (int k = 0; k < 2; ++k) dst[n][k] = *(const LAS bf16x8*)(lds + PG8_SB(b, h) + boff + n * 2048 + k * 1024); } while (0)
#define PG8_MMA(ai, bj, At, Bt) do { __builtin_amdgcn_s_setprio(1); _Pragma("unroll") for (int m = 0; m < 4; ++m) _Pragma("unroll") for (int n = 0; n < 2; ++n) _Pragma("unroll") for (int k = 0; k < 2; ++k) \
        acc[ai][bj][m][n] = __builtin_amdgcn_mfma_f32_16x16x32_bf16(Bt[n][k], At[m][k], acc[ai][bj][m][n], 0, 0, 0); __builtin_amdgcn_s_setprio(0); } while (0)
#define PG8_WAIT_V(n) asm volatile("s_waitcnt vmcnt(" #n ")" ::: "memory")
#define PG8_WAIT_L(n) asm volatile("s_waitcnt lgkmcnt(" #n ")" ::: "memory")
#define PG8_BAR __builtin_amdgcn_s_barrier()
#define PG8_SCHED __builtin_amdgcn_sched_barrier(0)
    GUnit cur, nxt; int ui = 0;
    if (!S.next(0, cur)) return;
    Acc acc;
#pragma unroll
    for (int a = 0; a < 2; ++a)
#pragma unroll
        for (int b = 0; b < 2; ++b)
#pragma unroll
            for (int m = 0; m < 4; ++m)
#pragma unroll
                for (int n = 0; n < 2; ++n) acc[a][b][m][n] = (f32x4){0.f, 0.f, 0.f, 0.f};
    bf16x8 At[4][2], B0[2][2], B1[2][2];
    unsigned uaC[2][2], uaN[2][2];
    if constexpr (Sched::TAB) { S.issue_tab(cur, tab, wid, lane); PG8_WAIT_V(0); __syncthreads(); }
    S.aoffs(cur, tab, sR, sC, uaC);
    const char* cB = S.bbase(cur);
    PG8_STAGE_B(PG8_SB(0, 0), cB); PG8_STAGE_B(PG8_SB(0, 1), cB + hstepB); PG8_STAGE_A(PG8_SA(0, 0), uaC[0], 0); PG8_STAGE_A(PG8_SA(0, 1), uaC[1], 0);
    if (wr == 1) PG8_BAR;
    PG8_WAIT_V(2); PG8_BAR;
    PG8_STAGE_B(PG8_SB(1, 0), cB + kstep); PG8_STAGE_A(PG8_SA(1, 0), uaC[0], kstep); PG8_STAGE_B(PG8_SB(1, 1), cB + hstepB + kstep);
    PG8_WAIT_V(6); PG8_BAR;
    for (;;) {
        const bool has_next = S.next(ui + 1, nxt);
        LAS unsigned* const tabN = tab + ((ui + 1) % 3) * 256;
        if constexpr (Sched::TAB) { if (has_next) S.issue_tab(nxt, tabN, wid, lane); }
        const char* nB = has_next ? S.bbase(nxt) : cB;
        for (int t = 0; t < NT; t += 2) {
            const bool last = (t == NT - 2);
            if (last) { if (has_next) S.aoffs(nxt, tabN, sR, sC, uaN); else {
#pragma unroll
                for (int h = 0; h < 2; ++h)
#pragma unroll
                    for (int i = 0; i < 2; ++i) uaN[h][i] = uaC[h][i]; } }
            unsigned u2[2][2];
#pragma unroll
            for (int h = 0; h < 2; ++h)
#pragma unroll
                for (int i = 0; i < 2; ++i) u2[h][i] = last ? uaN[h][i] : uaC[h][i];
            const unsigned k1 = (unsigned)(t + 1) * kstep, k2 = last ? 0u : (unsigned)(t + 2) * kstep;
            const char* b2 = last ? nB : cB + (size_t)(t + 2) * kstep; const char* b3 = b2 + kstep;
            PG8_LDB(B0, 0, 0); PG8_LDB(B1, 0, 1); PG8_SCHED; PG8_LDA(At, 0, 0); PG8_STAGE_A(PG8_SA(1, 1), uaC[1], k1);
            PG8_WAIT_V(8); PG8_WAIT_L(0); PG8_BAR; PG8_MMA(0, 0, At, B0); PG8_MMA(0, 1, At, B1); PG8_BAR; PG8_SCHED;
            PG8_LDA(At, 0, 1); PG8_STAGE_B(PG8_SB(0, 0), b2); PG8_STAGE_B(PG8_SB(0, 1), b2 + hstepB); PG8_STAGE_A(PG8_SA(0, 0), u2[0], k2);
            PG8_WAIT_V(8); PG8_WAIT_L(0); PG8_BAR; PG8_MMA(1, 0, At, B0); PG8_MMA(1, 1, At, B1); PG8_BAR; PG8_SCHED;
            PG8_LDB(B0, 1, 0); PG8_LDB(B1, 1, 1); PG8_SCHED; PG8_LDA(At, 1, 0); PG8_STAGE_A(PG8_SA(0, 1), u2[1], k2);
            PG8_WAIT_V(8); PG8_WAIT_L(0); PG8_BAR; PG8_MMA(0, 0, At, B0); PG8_MMA(0, 1, At, B1); PG8_BAR; PG8_SCHED;
            PG8_LDA(At, 1, 1); PG8_STAGE_B(PG8_SB(1, 0), b3); PG8_STAGE_B(PG8_SB(1, 1), b3 + hstepB); PG8_STAGE_A(PG8_SA(1, 0), u2[0], k2 + kstep);
            PG8_WAIT_V(8); PG8_WAIT_L(0); PG8_BAR; PG8_MMA(1, 0, At, B0); PG8_MMA(1, 1, At, B1); PG8_BAR; PG8_SCHED;
        }
        if (wr == 0) PG8_BAR;
        E(acc, cur, wr, wc, fr, fq, tab + (ui % 3) * 256);
        if (!has_next) break;
#pragma unroll
        for (int a = 0; a < 2; ++a)
#pragma unroll
            for (int b = 0; b < 2; ++b)
#pragma unroll
                for (int m = 0; m < 4; ++m)
#pragma unroll
                    for (int n = 0; n < 2; ++n) acc[a][b][m][n] = (f32x4){0.f, 0.f, 0.f, 0.f};
        cur = nxt; cB = nB; ++ui;
#pragma unroll
        for (int h = 0; h < 2; ++h)
#pragma unroll
            for (int i = 0; i < 2; ++i) uaC[h][i] = uaN[h][i];
        if (wr == 1) PG8_BAR;
    }
    PG8_WAIT_V(0);
    PG8_BAR;
#undef PG8_SA
#undef PG8_SB
#undef PG8_STAGE_A
#undef PG8_STAGE_B
#undef PG8_LDA
#undef PG8_LDB
#undef PG8_MMA
#undef PG8_WAIT_V
#undef PG8_WAIT_L
#undef PG8_BAR
#undef PG8_SCHED
}

constexpr int NXCD = 8, WGM = 8;
struct DenseSched {
    static constexpr bool TAB = false;
    const bf16_t* A; const bf16_t* Bt; int nM, nN, nwg, G, c, lda;
    __device__ __forceinline__ void init(const bf16_t* A_, const bf16_t* Bt_, int M, int N, int G_, int c_, int lda_ = KD) { A = A_; Bt = Bt_; nM = M / BM; nN = N / BM; nwg = nM * nN; G = G_; c = c_; lda = lda_; }
    __device__ __forceinline__ bool next(int i, GUnit& u) const {
        const long L = (long)i * G + c; if (L >= nwg) return false;
        int wgid = (int)L; { const int q = nwg / NXCD, r = nwg % NXCD, xcd = wgid % NXCD, off = wgid / NXCD; wgid = (xcd < r ? xcd * (q + 1) : r * (q + 1) + (xcd - r) * q) + off; }
        const int nig = WGM * nN, gid = wgid / nig, fm = gid * WGM, gsz = (nM - fm) < WGM ? (nM - fm) : WGM;
        u.pm = fm + ((wgid % nig) % gsz); u.pn = (wgid % nig) / gsz; u.e = 0; u.rows = 256; return true;
    }
    __device__ __forceinline__ const char* abase() const { return (const char*)A; }
    __device__ __forceinline__ const char* bbase(const GUnit& u) const { return (const char*)Bt + (size_t)u.pn * (BM * KD * 2); }
    __device__ __forceinline__ void issue_tab(const GUnit&, LAS unsigned*, int, int) const {}
    __device__ __forceinline__ void aoffs(const GUnit& u, LAS unsigned*, const int (&sR)[2], const int (&sC)[2], unsigned (&ua)[2][2]) const {
#pragma unroll
        for (int h = 0; h < 2; ++h)
#pragma unroll
            for (int i = 0; i < 2; ++i) ua[h][i] = (unsigned)((u.pm * BM + h * HALF + sR[i]) * lda + sC[i]) * 2u;
    }
};
template <bool GATHER> struct MoeSched {
    static constexpr bool TAB = true;
    const LAS int* ulist; int nunits; const LAS int* tstart; const LAS int* ecnt;
    const bf16_t* A; const bf16_t* Wt; size_t wstride; const unsigned* toklist;
    __device__ __forceinline__ bool next(int i, GUnit& u) const {
        if (i >= nunits) return false; const int v = ulist[i]; u.e = v & 255; u.pm = (v >> 8) & 4095; u.pn = v >> 20;
        const int rem = ecnt[u.e] - u.pm * 256; u.rows = rem < 256 ? rem : 256; return true;
    }
    __device__ __forceinline__ const char* abase() const { return (const char*)A; }
    __device__ __forceinline__ const char* bbase(const GUnit& u) const { return (const char*)Wt + (size_t)u.e * wstride + (size_t)u.pn * (BM * KD * 2); }
    __device__ __forceinline__ void issue_tab(const GUnit& u, LAS unsigned* t, int wid, int lane) const {
        if (wid < 4) __builtin_amdgcn_global_load_lds((const unsigned*)(toklist + (size_t)u.e * ECAP + u.pm * 256 + wid * 64 + lane), (LAS unsigned*)(t + wid * 64), 4, 0, 0);
    }
    __device__ __forceinline__ void aoffs(const GUnit& u, LAS unsigned* t, const int (&sR)[2], const int (&sC)[2], unsigned (&ua)[2][2]) const {
#pragma unroll
        for (int h = 0; h < 2; ++h)
#pragma unroll
            for (int i = 0; i < 2; ++i) {
                const int r = h * HALF + sR[i];
                if constexpr (GATHER) { const unsigned s = t[r < u.rows ? r : 0]; ua[h][i] = (s >> 2) * (unsigned)(KD * 2) + (unsigned)sC[i] * 2u; }
                else ua[h][i] = (unsigned)(((tstart[u.e] + u.pm) * BM + r) * KD + sC[i]) * 2u;
            }
    }
};

struct EpiBf16Plain {
    bf16_t* O; int ldc;
    __device__ __forceinline__ void operator()(const Acc& acc, const GUnit& u, int wr, int wc, int fr, int fq, LAS unsigned*) const {
        const int row0 = u.pm * BM + wr * 64 + fr, col0 = u.pn * BM + wc * 64 + fq * 8;
#pragma unroll
        for (int ai = 0; ai < 2; ++ai)
#pragma unroll
            for (int m = 0; m < 4; ++m) { bf16_t* rowp = O + (size_t)(row0 + ai * HALF + m * 16) * ldc + col0;
#pragma unroll
                for (int bj = 0; bj < 2; ++bj) { const f32x4 v0 = acc[ai][bj][m][0], v1 = acc[ai][bj][m][1];
                    u32x4 w; w.x = cvt_pk_bf16(v0[0], v0[1]); w.y = cvt_pk_bf16(v0[2], v0[3]); w.z = cvt_pk_bf16(v1[0], v1[1]); w.w = cvt_pk_bf16(v1[2], v1[3]);
                    *(u32x4*)(rowp + bj * 32) = w; } }
    }
};
struct EpiQKV {
    bf16_t* O; const int* pos; const float* qg; const float* kg;
    __device__ __forceinline__ void operator()(const Acc& acc, const GUnit& u, int wr, int wc, int fr, int fq, LAS unsigned*) const {
        const int g = u.pn / 12, s = (u.pn % 12) >> 2;
        const int row0 = u.pm * BM + wr * 64 + fr, col0 = u.pn * BM + wc * 64 + fq * 8;
        if (s == 2) {
#pragma unroll
            for (int ai = 0; ai < 2; ++ai)
#pragma unroll
                for (int m = 0; m < 4; ++m) { bf16_t* rowp = O + (size_t)(row0 + ai * HALF + m * 16) * NQKV + col0;
#pragma unroll
                    for (int bj = 0; bj < 2; ++bj) { const f32x4 v0 = acc[ai][bj][m][0], v1 = acc[ai][bj][m][1];
                        u32x4 w; w.x = cvt_pk_bf16(v0[0], v0[1]); w.y = cvt_pk_bf16(v0[2], v0[3]); w.z = cvt_pk_bf16(v1[0], v1[1]); w.w = cvt_pk_bf16(v1[2], v1[3]);
                        *(u32x4*)(rowp + bj * 32) = w; } }
            return;
        }
        const float* gain = (s == 0 ? qg : kg) + g * 64; const float sc = (s == 0) ? 0.125f * LOG2E : 1.0f;
#pragma unroll
        for (int ai = 0; ai < 2; ++ai)
#pragma unroll
            for (int m = 0; m < 4; ++m) {
                const int row = row0 + ai * HALF + m * 16; const float p = (float)pos[row];
                int gofs = 8 * fq; asm volatile("" : "+v"(gofs));
                const f32x4 ga = *(const f32x4*)(gain + gofs), gb = *(const f32x4*)(gain + gofs + 4), gc = *(const f32x4*)(gain + gofs + 32), gd = *(const f32x4*)(gain + gofs + 36);
                float v1[8], v2[8]; float ss = 0.f;
#pragma unroll
                for (int n = 0; n < 2; ++n)
#pragma unroll
                    for (int j = 0; j < 4; ++j) { v1[4 * n + j] = acc[ai][0][m][n][j]; v2[4 * n + j] = acc[ai][1][m][n][j]; ss += v1[4 * n + j] * v1[4 * n + j] + v2[4 * n + j] * v2[4 * n + j]; }
                ss += __shfl_xor(ss, 16); ss += __shfl_xor(ss, 32);
                const float rinv = __builtin_amdgcn_rsqf(ss * (1.0f / 64.0f) + RMS_EPS) * sc;
                float o1[8], o2[8];
#pragma unroll
                for (int i = 0; i < 8; ++i) { const float t1 = v1[i] * rinv * (i < 4 ? ga[i & 3] : gb[i & 3]), t2 = v2[i] * rinv * (i < 4 ? gc[i & 3] : gd[i & 3]);
                    const float invf = __builtin_amdgcn_exp2f(-(float)(gofs + i) * (13.287712379549449f / 32.0f)) * 0.15915494309189535f;
                    const float rev = __builtin_amdgcn_fractf(p * invf); const float cs = __builtin_amdgcn_cosf(rev), sn = __builtin_amdgcn_sinf(rev);
                    o1[i] = t1 * cs - t2 * sn; o2[i] = t2 * cs + t1 * sn; }
                bf16_t* rowp = O + (size_t)row * NQKV + col0;
                u32x4 w; w.x = cvt_pk_bf16(o1[0], o1[1]); w.y = cvt_pk_bf16(o1[2], o1[3]); w.z = cvt_pk_bf16(o1[4], o1[5]); w.w = cvt_pk_bf16(o1[6], o1[7]);
                *(u32x4*)(rowp) = w;
                w.x = cvt_pk_bf16(o2[0], o2[1]); w.y = cvt_pk_bf16(o2[2], o2[3]); w.z = cvt_pk_bf16(o2[4], o2[5]); w.w = cvt_pk_bf16(o2[6], o2[7]);
                *(u32x4*)(rowp + 32) = w;
                __builtin_amdgcn_sched_barrier(0);
            }
    }
};
struct EpiResid {
    const float* Xi; float* Xo; const float* gate;
    __device__ __forceinline__ void operator()(const Acc& acc, const GUnit& u, int wr, int wc, int fr, int fq, LAS unsigned*) const {
        const int row0 = u.pm * BM + wr * 64 + fr, col0 = u.pn * BM + wc * 32 + 4 * fq;
        const float* gp = gate + (size_t)((u.pm * BM) / SEQ) * 6144 + col0;
        f32x4 gv[2][2];
#pragma unroll
        for (int bj = 0; bj < 2; ++bj)
#pragma unroll
            for (int n = 0; n < 2; ++n) gv[bj][n] = *(const f32x4*)(gp + bj * HALF + n * 16);
#pragma unroll
        for (int ai = 0; ai < 2; ++ai)
#pragma unroll
            for (int m = 0; m < 4; ++m) { const size_t off = (size_t)(row0 + ai * HALF + m * 16) * D + col0;
#pragma unroll
                for (int bj = 0; bj < 2; ++bj)
#pragma unroll
                    for (int n = 0; n < 2; ++n) { const f32x4 xi = *(const f32x4*)(Xi + off + bj * HALF + n * 16); *(f32x4*)(Xo + off + bj * HALF + n * 16) = xi + gv[bj][n] * acc[ai][bj][m][n]; }
                asm volatile("" ::: "memory"); }
    }
};
struct EpiGLU {
    bf16_t* ACT; const float* bias; const LAS int* tstart;
    __device__ __forceinline__ void operator()(const Acc& acc, const GUnit& u, int wr, int wc, int fr, int fq, LAS unsigned*) const {
        const int c0 = u.pn * 128 + wc * 32 + fq * 8; const float* bp = bias + (size_t)u.e * 2048 + c0;
        const f32x4 bg0 = *(const f32x4*)(bp), bg1 = *(const f32x4*)(bp + 4), bu0 = *(const f32x4*)(bp + 1024), bu1 = *(const f32x4*)(bp + 1028);
        const size_t arow0 = (size_t)(tstart[u.e] + u.pm) * BM + wr * 64 + fr;
#pragma unroll
        for (int ai = 0; ai < 2; ++ai)
#pragma unroll
            for (int m = 0; m < 4; ++m) {
                const f32x4 ga = acc[ai][0][m][0] + bg0, gb = acc[ai][0][m][1] + bg1, ua = acc[ai][1][m][0] + bu0, ub = acc[ai][1][m][1] + bu1;
                float o[8];
#pragma unroll
                for (int j = 0; j < 4; ++j) {
                    { const float gt = __builtin_fminf(ga[j], 7.0f), up = __builtin_fminf(__builtin_fmaxf(ua[j], -7.0f), 7.0f);
                      const float sg = __builtin_amdgcn_rcpf(1.0f + __builtin_amdgcn_exp2f(-1.702f * LOG2E * gt)); o[j] = (up + 1.0f) * (gt * sg); }
                    { const float gt = __builtin_fminf(gb[j], 7.0f), up = __builtin_fminf(__builtin_fmaxf(ub[j], -7.0f), 7.0f);
                      const float sg = __builtin_amdgcn_rcpf(1.0f + __builtin_amdgcn_exp2f(-1.702f * LOG2E * gt)); o[4 + j] = (up + 1.0f) * (gt * sg); }
                }
                u32x4 w; w.x = cvt_pk_bf16(o[0], o[1]); w.y = cvt_pk_bf16(o[2], o[3]); w.z = cvt_pk_bf16(o[4], o[5]); w.w = cvt_pk_bf16(o[6], o[7]);
                *(u32x4*)(ACT + (arow0 + ai * HALF + m * 16) * D + c0) = w;
            }
    }
};
struct EpiDown {
    bf16_t* Y; const float* bias; const float* gatew;
    __device__ __forceinline__ void operator()(const Acc& acc, const GUnit& u, int wr, int wc, int fr, int fq, LAS unsigned* tab) const {
        const int col0 = u.pn * BM + wc * 64 + fq * 8; const float* bp = bias + (size_t)u.e * D + col0;
        f32x4 bv[2][2];
#pragma unroll
        for (int bj = 0; bj < 2; ++bj)
#pragma unroll
            for (int n = 0; n < 2; ++n) bv[bj][n] = *(const f32x4*)(bp + bj * 32 + n * 4);
#pragma unroll
        for (int ai = 0; ai < 2; ++ai)
#pragma unroll
            for (int m = 0; m < 4; ++m) {
                const int r = ai * HALF + wr * 64 + m * 16 + fr;
                if (r < u.rows) {
                    const unsigned slot = tab[r]; const float w = gatew[slot]; bf16_t* rowp = Y + (size_t)slot * D + col0;
#pragma unroll
                    for (int bj = 0; bj < 2; ++bj) { const f32x4 v0 = (acc[ai][bj][m][0] + bv[bj][0]) * w, v1 = (acc[ai][bj][m][1] + bv[bj][1]) * w;
                        u32x4 o; o.x = cvt_pk_bf16(v0[0], v0[1]); o.y = cvt_pk_bf16(v0[2], v0[3]); o.z = cvt_pk_bf16(v1[0], v1[1]); o.w = cvt_pk_bf16(v1[2], v1[3]);
                        *(u32x4*)(rowp + bj * 32) = o; }
                }
            }
    }
};
}

#define XB_TMO      128
#define XB_XCNT(j)  (256  + 64 * (j))
#define XB_XSUB(j)  (1280 + 64 * (j))
#define XB_XGEN(j)  (2304 + 64 * (j))
#define XB_TOP      3328
#define XB_TOPGEN   3392
#define XCD_BAR_WORDS 3456
#define XB_SPIN_CAP (1u << 18)
__device__ __forceinline__ unsigned xb_ld(unsigned* p)              { return __hip_atomic_load(p, __ATOMIC_RELAXED, __HIP_MEMORY_SCOPE_AGENT); }
__device__ __forceinline__ unsigned xb_add(unsigned* p, unsigned v) { return __hip_atomic_fetch_add(p, v, __ATOMIC_RELAXED, __HIP_MEMORY_SCOPE_AGENT); }
__device__ __forceinline__ unsigned xb_xcc_id() { return (unsigned)__builtin_amdgcn_s_getreg((3 << 11) | 20) & 0xFu; }
#define XB_SPIN(cond, bar) do { unsigned _sp = 0; while (cond) { __builtin_amdgcn_s_sleep(1); \
    if ((++_sp & 255u) == 0u) { if (xb_ld(&(bar)[XB_TMO])) break; if (_sp > XB_SPIN_CAP) { atomicAdd(&(bar)[XB_TMO], 1u); break; } } } } while (0)
struct XcdBarrier { unsigned* bar; unsigned x; volatile LAS unsigned* st; };
__device__ __forceinline__ XcdBarrier xcd_barrier_post(unsigned* bar, volatile LAS unsigned* st) {
    XcdBarrier b; b.bar = bar; b.x = xb_xcc_id(); b.st = st;
    if (threadIdx.x == 0) (void)xb_add(&bar[XB_XCNT(b.x)], 1u);
    return b;
}
__device__ __forceinline__ void xcd_barrier_complete(unsigned* bar, unsigned x, unsigned& nloc, unsigned& nx) {
    const unsigned G = gridDim.x * gridDim.y * gridDim.z;
    unsigned sum, cnt, mine, sp = 0u;
    for (;;) {
        sum = 0u; cnt = 0u; mine = 0u;
#pragma unroll
        for (unsigned j = 0; j < 16; ++j) { const unsigned c = xb_ld(&bar[XB_XCNT(j)]); sum += c; cnt += (c > 0u) ? 1u : 0u; mine = (j == x) ? c : mine; }
        if (sum == G) break;
        __builtin_amdgcn_s_sleep(1);
        if ((++sp & 255u) == 0u) { if (xb_ld(&bar[XB_TMO])) break; if (sp > XB_SPIN_CAP) { atomicAdd(&bar[XB_TMO], 1u); break; } }
    }
    nloc = mine > 0u ? mine : 1u; nx = cnt > 0u ? cnt : 1u;
}
__device__ __forceinline__ void xcd_barrier(const XcdBarrier& b) {
    asm volatile("s_waitcnt vmcnt(0)" ::: "memory");
    __syncthreads();
    if (threadIdx.x == 0) {
        unsigned* bar = b.bar;
        __builtin_amdgcn_s_waitcnt(0);
        unsigned nloc = b.st[0], nx = b.st[1];
        if (nloc == 0u) { xcd_barrier_complete(bar, b.x, nloc, nx); b.st[0] = nloc; b.st[1] = nx; }
        const unsigned old = xb_add(&bar[XB_XSUB(b.x)], 1u);
        const unsigned gen = old / nloc;
        if (old + 1u == (gen + 1u) * nloc) {
            __builtin_amdgcn_fence(__ATOMIC_RELEASE, "agent");
            asm volatile("s_waitcnt vmcnt(0)" ::: "memory");
            const unsigned og = xb_add(&bar[XB_TOP], 1u);
            const unsigned tg = og / nx;
            if (og + 1u == (tg + 1u) * nx) xb_add(&bar[XB_TOPGEN], 1u);
            else XB_SPIN(xb_ld(&bar[XB_TOPGEN]) == tg, bar);
            __builtin_amdgcn_fence(__ATOMIC_ACQUIRE, "agent");
            xb_add(&bar[XB_XGEN(b.x)], 1u);
            asm volatile("s_waitcnt vmcnt(0)" ::: "memory");
        } else {
            XB_SPIN(xb_ld(&bar[XB_XGEN(b.x)]) == gen, bar);
            __builtin_amdgcn_fence(__ATOMIC_ACQUIRE, "agent");
            asm volatile("s_waitcnt vmcnt(0)" ::: "memory");
        }
    }
    __syncthreads();
}

struct Args { const void* in[22]; float* out; unsigned char* ws; int ph_lo, ph_hi; };
#define A_x ((const float*)A.in[0])
#define A_c ((const float*)A.in[1])
#define A_pos ((const int*)A.in[2])
#define A_ada_w ((const float*)A.in[3])
#define A_ada_b ((const float*)A.in[4])
#define A_n1g ((const float*)A.in[5])
#define A_n2g ((const float*)A.in[6])
#define A_a_w_in ((const float*)A.in[7])
#define A_a_qg ((const float*)A.in[8])
#define A_a_kg ((const float*)A.in[9])
#define A_a_w_out ((const float*)A.in[10])
#define A_b_w_in ((const float*)A.in[11])
#define A_b_wg ((const float*)A.in[12])
#define A_b_gb ((const float*)A.in[13])
#define A_b_og ((const float*)A.in[14])
#define A_b_w_out ((const float*)A.in[15])
#define A_r_w ((const float*)A.in[16])
#define A_r_b ((const float*)A.in[17])
#define A_w_gu ((const float*)A.in[18])
#define A_b_gu ((const float*)A.in[19])
#define A_w_dn ((const float*)A.in[20])
#define A_b_dn ((const float*)A.in[21])
#define A_out (A.out)
#define A_mod ((float*)(A.ws + WS_MOD))
#define A_WTR ((bf16_t*)(A.ws + WS_WTR))
#define A_WTA ((bf16_t*)(A.ws + WS_WTA))
#define A_WAIN ((bf16_t*)(A.ws + WS_WAIN))
#define A_WAOUT ((bf16_t*)(A.ws + WS_WAOUT))
#define A_WBIN ((bf16_t*)(A.ws + WS_WBIN))
#define A_WBOUT ((bf16_t*)(A.ws + WS_WBOUT))
#define A_WGU ((bf16_t*)(A.ws + WS_WGU))
#define A_WDN ((bf16_t*)(A.ws + WS_WDN))
#define A_H ((bf16_t*)(A.ws + WS_H))
#define A_O ((bf16_t*)(A.ws + WS_O))
#define A_QKV ((bf16_t*)(A.ws + WS_R))
#define A_ACT ((bf16_t*)(A.ws + WS_ACT))
#define A_Y ((bf16_t*)(A.ws + WS_Y))
#define A_PROJ ((bf16_t*)(A.ws + WS_R))
#define A_LSE ((float*)(A.ws + WS_LSE))
#define A_APROJ ((float*)(A.ws + WS_APROJ))
#define A_GATEW ((float*)(A.ws + WS_GATEW))
#define A_XA ((float*)(A.ws + WS_XA))
#define A_TOKLIST ((unsigned*)(A.ws + WS_TOKLIST))
struct Frame {
    LAS unsigned char* lds;
    volatile LAS unsigned* MISC;
    gu32* ctl;
    int tid, lane, wave, G;
};
constexpr int NWAVES = 8;

__device__ __forceinline__ int perm5(int i) { return (((i >> 2) & 1) << 4) | ((i >> 3) << 2) | (i & 3); }
template <int MODE> __device__ __forceinline__ int dest_row(int n) {
    if (MODE == 0) return n;
    if (MODE == 1) return (n & ~255) | (((n >> 5) & 1) << 7) | (((n >> 6) & 3) << 5) | perm5(n & 31);
    const int bj = n >> 10, j = n & 1023; return ((j >> 7) << 8) | (bj << 7) | (((j >> 5) & 3) << 5) | perm5(j & 31);
}
template <int MODE> __device__ __forceinline__ void p0_transpose_item(const float* W, int ldw, int N, bf16_t* WT, LAS float* scr, int item, int lane) {
    const int nblk = N / 32, kb = item / nblk, nb = item % nblk, k0 = 64 * kb, n0 = 32 * nb;
#pragma unroll 8
    for (int i = 0; i < 32; ++i) { const int kk = 2 * i + (lane >> 5); scr[kk * 33 + (lane & 31)] = W[(size_t)(k0 + kk) * ldw + n0 + (lane & 31)]; }
    LDS_WAIT(); asm volatile("" ::: "memory");
    const int c = lane & 7;
#pragma unroll
    for (int j = 0; j < 4; ++j) { const int n = (lane >> 3) + 8 * j; const LAS float* s = scr + (8 * c) * 33 + n;
        u32x4 o; o.x = pk2(s[0 * 33], s[1 * 33]); o.y = pk2(s[2 * 33], s[3 * 33]); o.z = pk2(s[4 * 33], s[5 * 33]); o.w = pk2(s[6 * 33], s[7 * 33]);
        *(GAS u32x4*)(WT + (size_t)dest_row<MODE>(n0 + n) * 1024 + k0 + 8 * c) = o; }
    LDS_WAIT(); asm volatile("" ::: "memory");
}
__device__ __forceinline__ void p0_prologue(Frame& F, const Args& A) {
    LAS float* cond = (LAS float*)(F.lds + RING_OFF);
    for (int idx = F.tid; idx < NB * D; idx += NWAVES * 64) { const int b = idx >> 10, k = idx & 1023; const float v = A_c[idx]; cond[k * 8 + b] = v / (1.0f + __expf(-v)); }
    __syncthreads();
    const int gw = blockIdx.x * NWAVES + F.wave, NGW = F.G * NWAVES;
    for (int it = gw; it < 2 * 192; it += NGW) {
        const int l = it / 192, nb = it % 192, col = 32 * nb + (F.lane & 31), kh = F.lane >> 5;
        float acc[8];
#pragma unroll
        for (int b = 0; b < 8; ++b) acc[b] = 0.f;
        const float* wp = A_ada_w + ((size_t)l * D + kh * 512) * 6144 + col;
#pragma unroll 8
        for (int k = 0; k < 512; ++k) { const float w = wp[(size_t)k * 6144]; const f32x4 c0 = *(const LAS f32x4*)(cond + (kh * 512 + k) * 8), c1 = *(const LAS f32x4*)(cond + (kh * 512 + k) * 8 + 4);
            acc[0] += c0[0] * w; acc[1] += c0[1] * w; acc[2] += c0[2] * w; acc[3] += c0[3] * w; acc[4] += c1[0] * w; acc[5] += c1[1] * w; acc[6] += c1[2] * w; acc[7] += c1[3] * w; }
#pragma unroll
        for (int b = 0; b < 8; ++b) acc[b] += __shfl_xor(acc[b], 32);
        if (kh == 0) { const float bias = A_ada_b[l * 6144 + col];
#pragma unroll
            for (int b = 0; b < 8; ++b) A_mod[(size_t)(l * 8 + b) * 6144 + col] = acc[b] + bias; }
    }
    __syncthreads();
    LAS float* scr = (LAS float*)(F.lds + RING_OFF + F.wave * 16384);
    constexpr int I_AIN = 16 * (NQKV / 32), I_SQ = 16 * 32, I_BIN = 16 * (NPROJ / 32), I_GU = 16 * 64, I_DN = 16 * 32;
    constexpr int NITEMS = I_AIN + I_SQ + I_BIN + I_SQ + 64 * I_GU + 64 * I_DN;
    for (int it = gw; it < NITEMS; it += NGW) {
        int r = it;
        if (r < I_AIN) { p0_transpose_item<1>(A_a_w_in, NQKV, NQKV, A_WAIN, scr, r, F.lane); continue; } r -= I_AIN;
        if (r < I_SQ) { p0_transpose_item<0>(A_a_w_out, D, D, A_WAOUT, scr, r, F.lane); continue; } r -= I_SQ;
        if (r < I_BIN) { p0_transpose_item<1>(A_b_w_in, BIN_PITCH, NPROJ, A_WBIN, scr, r, F.lane); continue; } r -= I_BIN;
        if (r < I_SQ) { p0_transpose_item<0>(A_b_w_out, D, D, A_WBOUT, scr, r, F.lane); continue; } r -= I_SQ;
        if (r < 64 * I_GU) { const int mtx = r / I_GU; p0_transpose_item<2>(A_w_gu + (size_t)mtx * D * 2048, 2048, 2048, A_WGU + (size_t)mtx * 2048 * 1024, scr, r % I_GU, F.lane); continue; } r -= 64 * I_GU;
        { const int mtx = r / I_DN; p0_transpose_item<1>(A_w_dn + (size_t)mtx * D * D, D, D, A_WDN + (size_t)mtx * 1024 * 1024, scr, r % I_DN, F.lane); }
    }
    for (int idx = blockIdx.x * (NWAVES * 64) + F.tid; idx < 2 * 32 * 1024 + 16 * 1024; idx += F.G * NWAVES * 64) {
        if (idx < 2 * 32 * 1024) { const int l = idx >> 15, e = (idx >> 10) & 31, k = idx & 1023; const float v = A_r_w[((size_t)l * D + k) * NE + e];
            const unsigned h = f2bf(v); A_WTR[((size_t)(l * 2) * 32 + e) * 1024 + k] = (bf16_t)h; A_WTR[((size_t)(l * 2 + 1) * 32 + e) * 1024 + k] = (bf16_t)f2bf(v - __builtin_bit_cast(float, h << 16)); }
        else { const int i2 = idx - 2 * 32 * 1024, e = i2 >> 10, k = i2 & 1023; const float v = A_b_w_in[(size_t)k * BIN_PITCH + NPROJ + e];
            const unsigned h = f2bf(v); A_WTA[(size_t)e * 1024 + k] = (bf16_t)h; A_WTA[(size_t)(16 + e) * 1024 + k] = (bf16_t)f2bf(v - __builtin_bit_cast(float, h << 16)); }
    }
}

__device__ __forceinline__ void load_row(const float* p, int lane, f32x4 (&v)[4]) {
    const GAS f32x4* r = (const GAS f32x4*)p + lane;
#pragma unroll
    for (int j = 0; j < 4; ++j) v[j] = r[64 * j];
}
__device__ __forceinline__ void store_row(float* p, int lane, const f32x4 (&v)[4]) {
    GAS f32x4* r = (GAS f32x4*)p + lane;
#pragma unroll
    for (int j = 0; j < 4; ++j) r[64 * j] = v[j];
}
__device__ __forceinline__ void store_row_bf16(bf16_t* p, int lane, const f32x4 (&v)[4]) {
    GAS u32x2* r = (GAS u32x2*)p + lane;
#pragma unroll
    for (int j = 0; j < 4; ++j) { u32x2 w; w.x = pk2(v[j][0], v[j][1]); w.y = pk2(v[j][2], v[j][3]); r[64 * j] = w; }
}
__device__ __forceinline__ void norm_mod(f32x4 (&v)[4], const float* g, const float* scale, const float* shift, int lane) {
    float ss = 0.f;
#pragma unroll
    for (int j = 0; j < 4; ++j) ss += (v[j][0] * v[j][0] + v[j][1] * v[j][1]) + (v[j][2] * v[j][2] + v[j][3] * v[j][3]);
    const float rinv = __builtin_amdgcn_rsqf(wave_sum(ss) * (1.0f / D) + RMS_EPS);
    f32x4 gv[4], sv[4], hv[4]; load_row(g, lane, gv); load_row(scale, lane, sv); load_row(shift, lane, hv);
#pragma unroll
    for (int j = 0; j < 4; ++j) v[j] = v[j] * rinv * gv[j] * (sv[j] + 1.0f) + hv[j];
}
__device__ __forceinline__ void p_norm1(Frame& F, const Args& A, const float* X, int layer) {
    const int gw = blockIdx.x * NWAVES + F.wave, NGW = F.G * NWAVES;
    for (int m = gw; m < NTOK; m += NGW) {
        f32x4 v[4]; load_row(X + (size_t)m * D, F.lane, v);
        const float* md = A_mod + (size_t)(layer * 8 + m / SEQ) * 6144;
        norm_mod(v, A_n1g + layer * D, md + 1024, md, F.lane);
        store_row_bf16(A_H + (size_t)m * D, F.lane, v);
    }
}
constexpr int TP = 2048 + 64;
constexpr int WTILE = 8 * TP;
__device__ __forceinline__ void tile_put(LAS char* tile, int r, int lane, const f32x4 (&v)[4]) {
#pragma unroll
    for (int j = 0; j < 4; ++j) { u32x2 hi, lo; hi.x = pk2(v[j][0], v[j][1]); hi.y = pk2(v[j][2], v[j][3]);
        lo.x = pk2(v[j][0] - bflo(hi.x), v[j][1] - bfhi(hi.x)); lo.y = pk2(v[j][2] - bflo(hi.y), v[j][3] - bfhi(hi.y));
        *(LAS u32x2*)(tile + r * TP + 512 * j + 8 * lane) = hi; *(LAS u32x2*)(tile + (4 + r) * TP + 512 * j + 8 * lane) = lo; }
}
template <int NEB> __device__ __forceinline__ void rows4_proj(const LAS char* tile, const bf16_t* Wt, int lane, f32x4 (&acc)[NEB]) {
    const LAS char* ap = tile + (lane & 3) * TP + (lane >> 4) * 16;
    const bf16_t* bp = Wt + (size_t)(lane & 15) * 1024 + (lane >> 4) * 8;
#pragma unroll
    for (int eb = 0; eb < NEB; ++eb) acc[eb] = (f32x4){0.f, 0.f, 0.f, 0.f};
#pragma unroll 4
    for (int ks = 0; ks < 32; ++ks) {
        const bf16x8 ah = *(const LAS bf16x8*)(ap + ks * 64), al = *(const LAS bf16x8*)(ap + 4 * TP + ks * 64);
#pragma unroll
        for (int eb = 0; eb < NEB; ++eb) { const bf16x8 bh = *(const bf16x8*)(bp + eb * 16 * 1024 + ks * 32), bl = *(const bf16x8*)(bp + (NEB + eb) * 16 * 1024 + ks * 32);
            acc[eb] = __builtin_amdgcn_mfma_f32_16x16x32_bf16(ah, bh, acc[eb], 0, 0, 0);
            acc[eb] = __builtin_amdgcn_mfma_f32_16x16x32_bf16(ah, bl, acc[eb], 0, 0, 0);
            acc[eb] = __builtin_amdgcn_mfma_f32_16x16x32_bf16(al, bh, acc[eb], 0, 0, 0); }
    }
}
__device__ __forceinline__ void p_norm2_route(Frame& F, const Args& A, const float* X, int layer) {
    LAS char* tile = (LAS char*)(F.lds + RING_OFF + F.wave * WTILE);
    LAS int* sel_e = (LAS int*)(F.lds + SEL_OFF); LAS float* sel_w = (LAS float*)(F.lds + SEL_OFF + 2048);
    LAS unsigned* lcnt = (LAS unsigned*)(F.lds + MISC_OFF) + 16; LAS unsigned* lbase = (LAS unsigned*)(F.lds + MISC_OFF) + 48;
    if (F.tid < 32) lcnt[F.tid] = 0u;
    __syncthreads();
    const bf16_t* Wt = A_WTR + (size_t)layer * 2 * 32 * 1024;
    const int le = F.lane & 15;
    const float rb0 = A_r_b[layer * NE + le], rb1 = A_r_b[layer * NE + 16 + le];
    for (int ch = blockIdx.x; ch < NTOK / 128; ch += F.G) {
        const int tokbase = ch * 128;
#pragma unroll 1
        for (int g4 = 0; g4 < 4; ++g4) {
            const int tl = 16 * F.wave + 4 * g4;
#pragma unroll
            for (int r = 0; r < 4; ++r) { const int m = tokbase + tl + r; f32x4 h[4]; load_row(X + (size_t)m * D, F.lane, h);
                const float* md = A_mod + (size_t)(layer * 8 + m / SEQ) * 6144;
                norm_mod(h, A_n2g + layer * D, md + 4 * 1024, md + 3 * 1024, F.lane);
                store_row_bf16(A_H + (size_t)m * D, F.lane, h); tile_put(tile, r, F.lane, h); }
            LDS_WAIT(); asm volatile("" ::: "memory");
            f32x4 acc[2]; rows4_proj<2>(tile, Wt, F.lane, acc);
#pragma unroll
            for (int r = 0; r < 4; ++r) {
                const float va = acc[0][r] + rb0, vb = acc[1][r] + rb1;
                int ca = 0, cb = 0; float mx = __builtin_fmaxf(va, vb);
#pragma unroll 4
                for (int j = 0; j < 16; ++j) { const float la = __builtin_bit_cast(float, __builtin_amdgcn_readlane(__builtin_bit_cast(int, va), j)), lb = __builtin_bit_cast(float, __builtin_amdgcn_readlane(__builtin_bit_cast(int, vb), j));
                    ca += ((la > va || (la == va && j < le)) ? 1 : 0) + ((lb > va) ? 1 : 0);
                    cb += ((la >= vb) ? 1 : 0) + ((lb > vb || (lb == vb && j < le)) ? 1 : 0);
                    mx = __builtin_fmaxf(mx, __builtin_fmaxf(la, lb)); }
                const bool act = F.lane < 16, sa = act && ca < 4, sb = act && cb < 4;
                const float pa = sa ? __expf(va - mx) : 0.f, pb = sb ? __expf(vb - mx) : 0.f; const float sum = wave_sum(pa + pb);
                if (sa) { sel_e[(tl + r) * 4 + ca] = le; sel_w[(tl + r) * 4 + ca] = pa / sum; }
                if (sb) { sel_e[(tl + r) * 4 + cb] = 16 + le; sel_w[(tl + r) * 4 + cb] = pb / sum; }
            }
            LDS_WAIT(); asm volatile("" ::: "memory");
        }
        __syncthreads();
        const int e = sel_e[F.tid]; const float w = sel_w[F.tid];
        const unsigned rank = __hip_atomic_fetch_add(lcnt + e, 1u, __ATOMIC_RELAXED, __HIP_MEMORY_SCOPE_WORKGROUP);
        __syncthreads();
        if (F.tid < 32) { const unsigned n = lcnt[F.tid]; lbase[F.tid] = n ? __hip_atomic_fetch_add((unsigned*)(F.ctl + CW_CNT + (layer * 32 + F.tid) * 64), n, RLX_AGENT) : 0u; lcnt[F.tid] = 0u; }
        __syncthreads();
        const unsigned slot = (unsigned)(tokbase * 4 + F.tid);
        A_TOKLIST[(size_t)e * ECAP + lbase[e] + rank] = slot; A_GATEW[slot] = w;
#if MK_CHECK
        ((unsigned*)(A.ws + WS_DBG))[slot] = (unsigned)e;
#endif
        __syncthreads();
    }
}
template <bool NEXT> __device__ __forceinline__ void p_combine(Frame& F, const Args& A, const float* Xi, float* Xo, int layer) {
    LAS char* tile = (LAS char*)(F.lds + RING_OFF + F.wave * WTILE);
    const int gw = blockIdx.x * NWAVES + F.wave, NGW = F.G * NWAVES;
    for (int m4 = gw * 4; m4 < NTOK; m4 += NGW * 4) {
#pragma unroll
        for (int r = 0; r < 4; ++r) { const int m = m4 + r;
            f32x4 v[4]; load_row(Xi + (size_t)m * D, F.lane, v);
            const float* md = A_mod + (size_t)(layer * 8 + m / SEQ) * 6144;
            f32x4 g2[4]; load_row(md + 5 * 1024, F.lane, g2);
            f32x4 s[4];
#pragma unroll
            for (int j = 0; j < 4; ++j) s[j] = (f32x4){0.f, 0.f, 0.f, 0.f};
#pragma unroll
            for (int k = 0; k < 4; ++k) { const GAS u32x2* yr = (const GAS u32x2*)(A_Y + (size_t)(m * 4 + k) * D) + F.lane;
#pragma unroll
                for (int j = 0; j < 4; ++j) { const u32x2 w = yr[64 * j]; s[j][0] += bflo(w.x); s[j][1] += bfhi(w.x); s[j][2] += bflo(w.y); s[j][3] += bfhi(w.y); } }
#pragma unroll
            for (int j = 0; j < 4; ++j) v[j] = v[j] + g2[j] * s[j];
            store_row(Xo + (size_t)m * D, F.lane, v);
            if (NEXT) {
                const float* md1 = A_mod + (size_t)((layer + 1) * 8 + m / SEQ) * 6144;
                norm_mod(v, A_n1g + (layer + 1) * D, md1 + 1024, md1, F.lane);
                store_row_bf16(A_H + (size_t)m * D, F.lane, v); tile_put(tile, r, F.lane, v);
            }
            asm volatile("" ::: "memory");
        }
        if (NEXT) {
            LDS_WAIT(); asm volatile("" ::: "memory");
            f32x4 acc[1]; rows4_proj<1>(tile, A_WTA, F.lane, acc);
            if (F.lane < 16) {
#pragma unroll
                for (int r = 0; r < 4; ++r) A_APROJ[(size_t)(m4 + r) * 16 + F.lane] = acc[0][r]; }
            LDS_WAIT(); asm volatile("" ::: "memory");
        }
    }
}

namespace att {
constexpr int NK = 384, KCH = NK * 16 + 16, VH = NK * 64 + 64;
constexpr int K_OFF = 0, V_OFF = 8 * KCH, ST_OFF = V_OFF + 2 * VH, WS_OFF = ST_OFF + 8 * 4096, BYTES = WS_OFF + 8 * 256;
static_assert(RING_OFF + BYTES <= LDS_BYTES, "attention LDS");
template <int GRP> __device__ __forceinline__ void unit(Frame& F, const Args& A, int b, int h, int r, int blk) {
    constexpr int dil = (GRP == 0) ? 1 : (GRP == 1) ? 4 : 16;
    const int tid = F.tid, lane = F.lane, r32 = lane & 31, hi = lane >> 5, w = F.wave;
    const int u0 = blk * 256; const size_t rowb = (size_t)b * SEQ;
    int r32m = r32, tidm = tid, him = hi; asm volatile("" : "+v"(r32m), "+v"(tidm), "+v"(him));
    const bf16_t* Qg = A_QKV + GRP * 3072 + h * 64;
    LAS char* lds = (LAS char*)(F.lds + RING_OFF);
    u32x4 kv[6], vv[6];
#pragma unroll
    for (int i = 0; i < 6; ++i) { const int p = tid + 512 * i, key = p >> 3, c = p & 7, up = u0 - 128 + key;
        if (up >= 0) { const bf16_t* src = Qg + (rowb + (size_t)up * dil + r) * NQKV + c * 8; kv[i] = *(const u32x4*)(src + 1024); vv[i] = *(const u32x4*)(src + 2048); }
        else { kv[i] = (u32x4){0u, 0u, 0u, 0u}; vv[i] = kv[i]; } }
    bf16x8 qr[4];
    { const bf16_t* qp = Qg + (rowb + (size_t)(u0 + 32 * w + r32) * dil + r) * NQKV + hi * 8;
#pragma unroll
      for (int d0 = 0; d0 < 4; ++d0) qr[d0] = *(const bf16x8*)(qp + d0 * 16); }
#pragma unroll
    for (int i = 0; i < 6; ++i) { const int p = tidm + 512 * i, key = p >> 3, c = p & 7;
        *(LAS u32x4*)(lds + K_OFF + c * KCH + key * 16) = kv[i];
        *(LAS u32x4*)(lds + V_OFF + (c >> 2) * VH + key * 64 + (c & 3) * 16) = vv[i]; }
    __syncthreads();
    const int lo = (blk == 0) ? ((4 - w) > 0 ? (4 - w) : 0) : 0;
    f32x16 s[5];
    const float NEG = -INFINITY;
#pragma unroll
    for (int kp = 0; kp < 5; ++kp) {
        f32x16 a;
#pragma unroll
        for (int q = 0; q < 16; ++q) a[q] = (kp >= lo) ? 0.f : NEG;
        if (kp >= lo) {
            const LAS char* kb = lds + K_OFF + hi * KCH + ((w + kp) * 32 + r32) * 16;
#pragma unroll
            for (int d0 = 0; d0 < 4; ++d0) { const bf16x8 kf = *(const LAS bf16x8*)(kb + 2 * d0 * KCH); a = __builtin_amdgcn_mfma_f32_32x32x16_bf16(kf, qr[d0], a, 0, 0, 0); }
            if (kp == 0) {
#pragma unroll
                for (int q = 0; q < 16; ++q) if (crow(q, him) < r32m) a[q] = NEG; }
            if (kp == 4) {
#pragma unroll
                for (int q = 0; q < 16; ++q) if (crow(q, him) > r32m) a[q] = NEG; }
        }
        s[kp] = a;
    }
    float m = NEG;
#pragma unroll
    for (int kp = 0; kp < 5; ++kp)
#pragma unroll
        for (int q = 0; q < 16; ++q) m = __builtin_fmaxf(m, s[kp][q]);
    m = __builtin_fmaxf(m, __shfl_xor(m, 32));
    float l = 0.f;
#pragma unroll
    for (int kp = 0; kp < 5; ++kp)
#pragma unroll
        for (int q = 0; q < 16; ++q) { const float p = __builtin_amdgcn_exp2f(s[kp][q] - m); s[kp][q] = p; l += p; }
    l += __shfl_xor(l, 32);
    f32x16 o[2];
#pragma unroll
    for (int q = 0; q < 16; ++q) { o[0][q] = 0.f; o[1][q] = 0.f; }
    const LAS char* vb = lds + V_OFF + ((lane >> 4) & 1) * 32 + (lane & 3) * 8 + (4 * hi + ((lane & 15) >> 2)) * 64;
#pragma unroll
    for (int kp = 0; kp < 5; ++kp) {
        if (kp >= lo) {
            u32x4 pw0, pw1;
            pw0.x = cvt_pk_bf16(s[kp][0], s[kp][1]); pw0.y = cvt_pk_bf16(s[kp][2], s[kp][3]); pw0.z = cvt_pk_bf16(s[kp][4], s[kp][5]); pw0.w = cvt_pk_bf16(s[kp][6], s[kp][7]);
            pw1.x = cvt_pk_bf16(s[kp][8], s[kp][9]); pw1.y = cvt_pk_bf16(s[kp][10], s[kp][11]); pw1.z = cvt_pk_bf16(s[kp][12], s[kp][13]); pw1.w = cvt_pk_bf16(s[kp][14], s[kp][15]);
            const bf16x8 pa0 = __builtin_bit_cast(bf16x8, pw0), pa1 = __builtin_bit_cast(bf16x8, pw1);
#pragma unroll
            for (int d0 = 0; d0 < 2; ++d0) {
                const LAS char* vp = vb + d0 * VH + ((w + kp) * 32) * 64;
                const s16x4 l0 = tr_read(vp), h0 = tr_read(vp + 512), l1 = tr_read(vp + 1024), h1 = tr_read(vp + 1536);
                o[d0] = __builtin_amdgcn_mfma_f32_32x32x16_bf16(pa0, CAT8(l0, h0), o[d0], 0, 0, 0);
                o[d0] = __builtin_amdgcn_mfma_f32_32x32x16_bf16(pa1, CAT8(l1, h1), o[d0], 0, 0, 0);
            }
        }
    }
    LAS float* wsf = (LAS float*)(lds + WS_OFF + w * 256);
    LAS bf16_t* stg = (LAS bf16_t*)(lds + ST_OFF + w * 4096);
    if (hi == 0) { wsf[r32] = __builtin_amdgcn_rcpf(l); wsf[32 + r32] = m + __builtin_amdgcn_logf(l); }
    LDS_WAIT(); asm volatile("" ::: "memory");
    int hie = hi; asm volatile("" : "+v"(hie));
#pragma unroll
    for (int q = 0; q < 16; ++q) { const int orow = crow(q, hie); const float rl = wsf[orow];
        stg[orow * 64 + r32] = (bf16_t)f2bf(o[0][q] * rl); stg[orow * 64 + 32 + r32] = (bf16_t)f2bf(o[1][q] * rl); }
    LDS_WAIT(); asm volatile("" ::: "memory");
#pragma unroll
    for (int i = 0; i < 4; ++i) {
        const int row = i * 8 + (lane >> 3), ch = lane & 7;
        u32x4 v = *(const LAS u32x4*)(stg + row * 64 + ch * 8);
        const size_t grow = rowb + (size_t)(u0 + 32 * w + row) * dil + r;
        bf16_t* op = A_O + grow * D + h * 64 + ch * 8; float* lp = A_LSE + grow * 16 + h;
        float ln = wsf[32 + row];
        if (GRP > 0) {
            const u32x4 old = *(const u32x4*)op; const float lold = *lp;
            const float mx = __builtin_fmaxf(lold, ln), L = mx + __builtin_amdgcn_logf(__builtin_amdgcn_exp2f(lold - mx) + __builtin_amdgcn_exp2f(ln - mx));
            const float wo = __builtin_amdgcn_exp2f(lold - L), wn = __builtin_amdgcn_exp2f(ln - L);
            v.x = cvt_pk_bf16(bflo(old.x) * wo + bflo(v.x) * wn, bfhi(old.x) * wo + bfhi(v.x) * wn);
            v.y = cvt_pk_bf16(bflo(old.y) * wo + bflo(v.y) * wn, bfhi(old.y) * wo + bfhi(v.y) * wn);
            v.z = cvt_pk_bf16(bflo(old.z) * wo + bflo(v.z) * wn, bfhi(old.z) * wo + bfhi(v.z) * wn);
            v.w = cvt_pk_bf16(bflo(old.w) * wo + bflo(v.w) * wn, bfhi(old.w) * wo + bfhi(v.w) * wn);
            ln = L;
        }
        *(u32x4*)op = v; if (ch == 0) *lp = ln;
    }
    __syncthreads();
}
template <int GRP> __device__ __forceinline__ void phase(Frame& F, const Args& A) {
    constexpr int dil = (GRP == 0) ? 1 : (GRP == 1) ? 4 : 16;
    for (int id = blockIdx.x; id < NB * 16 * 16; id += F.G) { const int bh = id >> 4, wi = id & 15; unit<GRP>(F, A, bh >> 4, bh & 15, wi % dil, wi / dil); }
}
}

namespace gla {
constexpr int QCH = 64 * 16 + 16;
constexpr int TH = 64 * 64 + 64;
constexpr int QD_OFF = 0, KI_OFF = 16 * QCH, KD_OFF = 32 * QCH, V_OFF = KD_OFF + 4 * TH, OST_OFF = V_OFF + 8 * TH, OSTP = 528;
constexpr int A_OFF = OST_OFF + 64 * OSTP, SEG_OFF = A_OFF + 4096, DEC_OFF = SEG_OFF + 2048, WG_OFF = DEC_OFF + 512, BYTES = WG_OFF + 16 * 128 * 4;
static_assert(RING_OFF + BYTES <= LDS_BYTES, "gla LDS");
__device__ __forceinline__ int swap23(int d) { return (d & ~12) | ((d & 4) << 1) | ((d & 8) >> 1); }
__device__ __forceinline__ void phase(Frame& F, const Args& A) {
    if ((int)blockIdx.x >= NB * 4) return;
    const int b = blockIdx.x >> 2, hd = blockIdx.x & 3;
    const int lane = F.lane, r32 = lane & 31, hi = lane >> 5, w = F.wave;
    LAS char* lds = (LAS char*)(F.lds + RING_OFF);
    const int d = F.tid & 127, seg = F.tid >> 7;
    if (seg == 0) {
#pragma unroll
        for (int j = 0; j < 16; ++j) ((LAS float*)(lds + WG_OFF))[j * 128 + d] = A_b_wg[j * 512 + hd * 128 + d]; }
    const float gbias = A_b_gb[hd * 128 + d];
    f32x16 S[4];
#pragma unroll
    for (int k = 0; k < 4; ++k)
#pragma unroll
        for (int q = 0; q < 16; ++q) S[k][q] = 0.f;
    const LAS char* trb = lds + ((lane >> 4) & 1) * 32 + (lane & 3) * 8 + (4 * hi + ((lane & 15) >> 2)) * 64;
#pragma unroll 1
    for (int n = 0; n < SEQ / 64; ++n) {
        const size_t row0 = (size_t)b * SEQ + n * 64;
        int tid = F.tid; asm volatile("" : "+v"(tid));
        const int d = tid & 127, seg = tid >> 7, c_n = tid >> 3, sg_n = tid & 7;
        const int dsw = swap23(d);
        const int qwoff = (dsw >> 3) * QCH + (dsw & 7) * 2;
        const int kdoff = KD_OFF + (d >> 5) * TH + (d & 31) * 2;
        if (tid < 256) *(LAS f32x4*)(lds + A_OFF + tid * 16) = *(const f32x4*)(A_APROJ + row0 * 16 + tid * 4);
#pragma unroll
        for (int i = 0; i < 4; ++i) { const int p = tid + 512 * i, c = p >> 5, ch = p & 31;
            const u32x4 v = *(const u32x4*)(A_PROJ + (row0 + c) * NPROJ + 1024 + hd * 256 + ch * 8);
            *(LAS u32x4*)(lds + V_OFF + (ch >> 2) * TH + c * 64 + (ch & 3) * 16) = v; }
        unsigned qk[16];
#pragma unroll
        for (int i = 0; i < 16; ++i) { const bf16_t* pr = A_PROJ + (row0 + 16 * seg + i) * NPROJ + hd * 128 + d; qk[i] = (unsigned)pr[0] | ((unsigned)pr[512] << 16); }
        __syncthreads();
        float cs[16]; float run = 0.f;
#pragma unroll
        for (int i = 0; i < 16; ++i) { const LAS f32x4* ap = (const LAS f32x4*)(lds + A_OFF + (16 * seg + i) * 64); float z = gbias;
#pragma unroll
            for (int j4 = 0; j4 < 4; ++j4) { const f32x4 a = ap[j4]; const LAS float* wgp = (const LAS float*)(lds + WG_OFF) + d;
                z += a[0] * wgp[(4 * j4) * 128] + a[1] * wgp[(4 * j4 + 1) * 128] + a[2] * wgp[(4 * j4 + 2) * 128] + a[3] * wgp[(4 * j4 + 3) * 128]; }
            const float sp = __builtin_fmaxf(-z, 0.f) + __logf(1.0f + __expf(-__builtin_fabsf(z)));
            run -= sp * (LOG2E / 16.0f); cs[i] = run; }
        ((LAS float*)(lds + SEG_OFF))[seg * 128 + d] = run;
        __syncthreads();
        float pre = 0.f, tot = 0.f;
#pragma unroll
        for (int s2 = 0; s2 < 4; ++s2) { const float t = ((const LAS float*)(lds + SEG_OFF))[s2 * 128 + d]; if (s2 < seg) pre += t; tot += t; }
        if (seg == 0) ((LAS float*)(lds + DEC_OFF))[d] = __builtin_amdgcn_exp2f(tot);
#pragma unroll
        for (int i = 0; i < 16; ++i) { const int c = 16 * seg + i; const float bb = pre + cs[i];
            const float eb = __builtin_amdgcn_exp2f(bb), enb = __builtin_amdgcn_exp2f(-bb), elb = __builtin_amdgcn_exp2f(tot - bb);
            const float qf = bflo(qk[i]), kf = bfhi(qk[i]);
            *(LAS bf16_t*)(lds + QD_OFF + qwoff + c * 16) = (bf16_t)f2bf(qf * 0.08838834764831845f * eb);
            *(LAS bf16_t*)(lds + KI_OFF + qwoff + c * 16) = (bf16_t)f2bf(kf * enb);
            *(LAS bf16_t*)(lds + kdoff + c * 64) = (bf16_t)f2bf(kf * elb); }
        __syncthreads();
        f32x16 o[2];
#pragma unroll
        for (int q = 0; q < 16; ++q) { o[0][q] = 0.f; o[1][q] = 0.f; }
        const LAS char* vtr = trb + V_OFF + w * TH;
#define GLA_PK(A, B) __builtin_bit_cast(bf16x8, (u32x4){cvt_pk_bf16(A[B], A[B + 1]), cvt_pk_bf16(A[B + 2], A[B + 3]), cvt_pk_bf16(A[B + 4], A[B + 5]), cvt_pk_bf16(A[B + 6], A[B + 7])})
        const LAS char* kp = lds + KI_OFF + hi * QCH + r32 * 16; const LAS char* qp = lds + QD_OFF + hi * QCH + r32 * 16;
        bf16x8 v0, v1, v2, v3;
        {
            { const s16x4 l0 = tr_read(vtr), h0 = tr_read(vtr + 512), l1 = tr_read(vtr + 1024), h1 = tr_read(vtr + 1536); v0 = CAT8(l0, h0); v1 = CAT8(l1, h1); }
            { f32x16 a00;
#pragma unroll
              for (int q = 0; q < 16; ++q) a00[q] = 0.f;
#pragma unroll
              for (int ks = 0; ks < 8; ++ks) a00 = __builtin_amdgcn_mfma_f32_32x32x16_bf16(*(const LAS bf16x8*)(kp + 2 * ks * QCH), *(const LAS bf16x8*)(qp + 2 * ks * QCH), a00, 0, 0, 0);
#pragma unroll
              for (int q = 0; q < 16; ++q) if (crow(q, hi) > r32) a00[q] = 0.f;
              o[0] = __builtin_amdgcn_mfma_f32_32x32x16_bf16(GLA_PK(a00, 0), v0, o[0], 0, 0, 0);
              o[0] = __builtin_amdgcn_mfma_f32_32x32x16_bf16(GLA_PK(a00, 8), v1, o[0], 0, 0, 0); }
            __builtin_amdgcn_sched_barrier(0);
            { f32x16 a01;
#pragma unroll
              for (int q = 0; q < 16; ++q) a01[q] = 0.f;
#pragma unroll
              for (int ks = 0; ks < 8; ++ks) a01 = __builtin_amdgcn_mfma_f32_32x32x16_bf16(*(const LAS bf16x8*)(kp + 2 * ks * QCH), *(const LAS bf16x8*)(qp + 2 * ks * QCH + 512), a01, 0, 0, 0);
              o[1] = __builtin_amdgcn_mfma_f32_32x32x16_bf16(GLA_PK(a01, 0), v0, o[1], 0, 0, 0);
              o[1] = __builtin_amdgcn_mfma_f32_32x32x16_bf16(GLA_PK(a01, 8), v1, o[1], 0, 0, 0); }
            __builtin_amdgcn_sched_barrier(0);
            { const s16x4 l2 = tr_read(vtr + 2048), h2 = tr_read(vtr + 2560), l3 = tr_read(vtr + 3072), h3 = tr_read(vtr + 3584); v2 = CAT8(l2, h2); v3 = CAT8(l3, h3); }
            { f32x16 a11;
#pragma unroll
              for (int q = 0; q < 16; ++q) a11[q] = 0.f;
#pragma unroll
              for (int ks = 0; ks < 8; ++ks) a11 = __builtin_amdgcn_mfma_f32_32x32x16_bf16(*(const LAS bf16x8*)(kp + 2 * ks * QCH + 512), *(const LAS bf16x8*)(qp + 2 * ks * QCH + 512), a11, 0, 0, 0);
#pragma unroll
              for (int q = 0; q < 16; ++q) if (crow(q, hi) > r32) a11[q] = 0.f;
              o[1] = __builtin_amdgcn_mfma_f32_32x32x16_bf16(GLA_PK(a11, 0), v2, o[1], 0, 0, 0);
              o[1] = __builtin_amdgcn_mfma_f32_32x32x16_bf16(GLA_PK(a11, 8), v3, o[1], 0, 0, 0); }
            __builtin_amdgcn_sched_barrier(0);
#pragma unroll
            for (int k = 0; k < 4; ++k)
#pragma unroll
                for (int s2 = 0; s2 < 2; ++s2) { const bf16x8 sb = GLA_PK(S[k], 8 * s2);
                    const bf16x8 q0 = *(const LAS bf16x8*)(qp + (4 * k + 2 * s2) * QCH), q1 = *(const LAS bf16x8*)(qp + (4 * k + 2 * s2) * QCH + 512);
                    o[0] = __builtin_amdgcn_mfma_f32_32x32x16_bf16(q0, sb, o[0], 0, 0, 0);
                    o[1] = __builtin_amdgcn_mfma_f32_32x32x16_bf16(q1, sb, o[1], 0, 0, 0); }
#pragma unroll
            for (int k = 0; k < 4; ++k) {
#pragma unroll
                for (int q4 = 0; q4 < 4; ++q4) { const f32x4 dc = *(const LAS f32x4*)(lds + DEC_OFF + (32 * k + 8 * q4 + 4 * hi) * 4);
                    S[k][4 * q4] *= dc[0]; S[k][4 * q4 + 1] *= dc[1]; S[k][4 * q4 + 2] *= dc[2]; S[k][4 * q4 + 3] *= dc[3]; }
                const LAS char* ktr = trb + KD_OFF + k * TH;
                const s16x4 kl0 = tr_read(ktr), kh0 = tr_read(ktr + 512), kl1 = tr_read(ktr + 1024), kh1 = tr_read(ktr + 1536);
                const s16x4 kl2 = tr_read(ktr + 2048), kh2 = tr_read(ktr + 2560), kl3 = tr_read(ktr + 3072), kh3 = tr_read(ktr + 3584);
                S[k] = __builtin_amdgcn_mfma_f32_32x32x16_bf16(CAT8(kl0, kh0), v0, S[k], 0, 0, 0);
                S[k] = __builtin_amdgcn_mfma_f32_32x32x16_bf16(CAT8(kl1, kh1), v1, S[k], 0, 0, 0);
                S[k] = __builtin_amdgcn_mfma_f32_32x32x16_bf16(CAT8(kl2, kh2), v2, S[k], 0, 0, 0);
                S[k] = __builtin_amdgcn_mfma_f32_32x32x16_bf16(CAT8(kl3, kh3), v3, S[k], 0, 0, 0);
            }
        }
#undef GLA_PK
#pragma unroll
        for (int cb = 0; cb < 2; ++cb)
#pragma unroll
            for (int q = 0; q < 16; ++q) *(LAS bf16_t*)(lds + OST_OFF + (32 * cb + crow(q, hi)) * OSTP + (32 * w + r32) * 2) = (bf16_t)f2bf(o[cb][q]);
        __syncthreads();
        { u32x4 ov[4]; float ss = 0.f;
#pragma unroll
          for (int i = 0; i < 4; ++i) { ov[i] = *(const LAS u32x4*)(lds + OST_OFF + c_n * OSTP + sg_n * 64 + i * 16);
              const float a0 = bflo(ov[i].x), a1 = bfhi(ov[i].x), a2 = bflo(ov[i].y), a3 = bfhi(ov[i].y), a4 = bflo(ov[i].z), a5 = bfhi(ov[i].z), a6 = bflo(ov[i].w), a7 = bfhi(ov[i].w);
              ss += (a0 * a0 + a1 * a1) + (a2 * a2 + a3 * a3) + (a4 * a4 + a5 * a5) + (a6 * a6 + a7 * a7); }
          ss += __shfl_xor(ss, 1); ss += __shfl_xor(ss, 2); ss += __shfl_xor(ss, 4);
          const float rinv = __builtin_amdgcn_rsqf(ss * (1.0f / 256.0f) + RMS_EPS);
          const bf16_t* rp = A_PROJ + (row0 + c_n) * NPROJ + 2048 + hd * 256 + 32 * sg_n;
          bf16_t* op = A_O + (row0 + c_n) * D + hd * 256 + 32 * sg_n;
#pragma unroll
          for (int i = 0; i < 4; ++i) { const u32x4 rv = *(const u32x4*)(rp + 8 * i); u32x4 res; float og[8];
              { const f32x4 g0 = *(const f32x4*)(A_b_og + 32 * sg_n + 8 * i), g1 = *(const f32x4*)(A_b_og + 32 * sg_n + 8 * i + 4); og[0] = g0[0]; og[1] = g0[1]; og[2] = g0[2]; og[3] = g0[3]; og[4] = g1[0]; og[5] = g1[1]; og[6] = g1[2]; og[7] = g1[3]; }
              const unsigned ow[4] = {ov[i].x, ov[i].y, ov[i].z, ov[i].w}, rw[4] = {rv.x, rv.y, rv.z, rv.w}; unsigned out[4];
#pragma unroll
              for (int j = 0; j < 4; ++j) { const float r0 = bflo(rw[j]), r1 = bfhi(rw[j]);
                  const float s0 = r0 * __builtin_amdgcn_rcpf(1.0f + __builtin_amdgcn_exp2f(-LOG2E * r0)), s1 = r1 * __builtin_amdgcn_rcpf(1.0f + __builtin_amdgcn_exp2f(-LOG2E * r1));
                  out[j] = cvt_pk_bf16(bflo(ow[j]) * rinv * og[2 * j] * s0, bfhi(ow[j]) * rinv * og[2 * j + 1] * s1); }
              res.x = out[0]; res.y = out[1]; res.z = out[2]; res.w = out[3];
              *(u32x4*)(op + 8 * i) = res; } }
        __syncthreads();
    }
}
}

__device__ __forceinline__ int moe_build_units(Frame& F, const Args& A, int layer, int npn) {
    LAS int* tstart = (LAS int*)(F.lds + MISC_OFF) + 80; LAS int* ecnt = (LAS int*)(F.lds + MISC_OFF) + 128; LAS int* ulist = (LAS int*)(F.lds + SEL_OFF);
    if (F.tid < 32) ecnt[F.tid] = (int)__hip_atomic_load((unsigned*)(F.ctl + CW_CNT + (layer * 32 + F.tid) * 64), RLX_AGENT);
    __syncthreads();
    if (F.tid == 0) { int s = 0; for (int e = 0; e < 32; ++e) { tstart[e] = s; s += (ecnt[e] + 255) >> 8; } tstart[32] = s; }
    __syncthreads();
    const int utot = tstart[32] * npn;
    int lo, hi, step, first;
    if (F.G % 8 == 0) { const int x = blockIdx.x % 8; lo = (int)(((long)utot * x) / 8); hi = (int)(((long)utot * (x + 1)) / 8); step = F.G / 8; first = blockIdx.x / 8; }
    else { lo = 0; hi = utot; step = F.G; first = blockIdx.x; }
    const int span = hi - lo - first; const int n = span > 0 ? (span + step - 1) / step : 0;
    if (F.tid < n && F.tid < 1024) {
        const int L = lo + first + step * F.tid, T = L / npn, pn = L % npn;
        int e = 0;
#pragma unroll
        for (int bit = 16; bit >= 1; bit >>= 1) if (e + bit < 32 && tstart[e + bit] <= T) e += bit;
        ulist[F.tid] = e | ((T - tstart[e]) << 8) | (pn << 20);
    }
    __syncthreads();
    return n < 512 ? n : 512;
}


#if MK_CHECK
__device__ __forceinline__ float bf16r(float v) { return __builtin_bit_cast(float, f2bf(v) << 16); }
__device__ __forceinline__ void dbg_check_moe(Frame& F, const Args& A, int layer) {
    LAS float* hrow = (LAS float*)(F.lds + RING_OFF); LAS float* act = hrow + 1024;
    float werr = 0.f, wref = 0.f;
    for (int s = blockIdx.x; s < 1024; s += F.G) {
        const unsigned slot = (unsigned)((s * 127 + 5) % NASSIGN); const int tok = slot >> 2; const int e = (int)((const unsigned*)(A.ws + WS_DBG))[slot]; const float w = A_GATEW[slot];
        for (int k = F.tid; k < 1024; k += 512) hrow[k] = __builtin_bit_cast(float, (unsigned)A_H[(size_t)tok * D + k] << 16);
        __syncthreads();
        const float* wgu = A_w_gu + ((size_t)layer * 32 + e) * D * 2048; const float* bgu = A_b_gu + ((size_t)layer * 32 + e) * 2048;
        for (int jj = 0; jj < 2; ++jj) { const int j = F.tid + 512 * jj; float g = 0.f, u = 0.f;
#pragma unroll 8
            for (int k = 0; k < 1024; ++k) { g += hrow[k] * bf16r(wgu[(size_t)k * 2048 + j]); u += hrow[k] * bf16r(wgu[(size_t)k * 2048 + 1024 + j]); }
            g += bgu[j]; u += bgu[1024 + j];
            const float gt = __builtin_fminf(g, 7.0f), up = __builtin_fminf(__builtin_fmaxf(u, -7.0f), 7.0f);
            act[j] = bf16r((up + 1.0f) * gt / (1.0f + __expf(-1.702f * gt))); }
        __syncthreads();
        const float* wdn = A_w_dn + ((size_t)layer * 32 + e) * D * D; const float* bdn = A_b_dn + ((size_t)layer * 32 + e) * D;
        for (int nn = 0; nn < 2; ++nn) { const int n = F.tid + 512 * nn; float y = 0.f;
#pragma unroll 8
            for (int j = 0; j < 1024; ++j) y += act[j] * bf16r(wdn[(size_t)j * D + n]);
            y = w * (y + bdn[n]);
            const float got = __builtin_bit_cast(float, (unsigned)A_Y[(size_t)slot * D + n] << 16);
            const float df = got - y; werr += (df == df) ? df * df : 1e6f; wref += y * y; }
        __syncthreads();
    }
    werr = wave_sum(werr); wref = wave_sum(wref);
    if (F.lane == 0) { atomicAdd((float*)(F.ctl + CW_DBG), werr); atomicAdd((float*)(F.ctl + CW_DBG + 1), wref); }
}
__device__ __forceinline__ void dbg_check_attn(Frame& F, const Args& A) {
    LAS float* sc = (LAS float*)(F.lds + RING_OFF);
    LAS float* red = sc + 512;
    float werr = 0.f, wref = 0.f;
    for (int s = blockIdx.x; s < 1024; s += F.G) {
        const int b = s & 7, t = ((s >> 3) * 33 + (s & 7) * 517) % SEQ, h = (s * 5) & 15; const size_t row = (size_t)b * SEQ + t;
        float sv = -INFINITY;
        if (F.tid < 387) { const int g = F.tid / 129, j = F.tid % 129, dil = (g == 0) ? 1 : (g == 1) ? 4 : 16; const int tj = t - j * dil;
            if (tj >= 0) { const bf16_t* qp = A_QKV + row * NQKV + g * 3072 + h * 64; const bf16_t* kp = A_QKV + ((size_t)b * SEQ + tj) * NQKV + g * 3072 + 1024 + h * 64; float a = 0.f;
                for (int d = 0; d < 64; ++d) a += __builtin_bit_cast(float, (unsigned)qp[d] << 16) * __builtin_bit_cast(float, (unsigned)kp[d] << 16);
                sv = a; } }
        sc[F.tid] = sv;
        __syncthreads();
        float m = -INFINITY; for (int i = 0; i < 387; ++i) m = __builtin_fmaxf(m, sc[i]);
        float l = 0.f; for (int i = 0; i < 387; ++i) l += __builtin_amdgcn_exp2f(sc[i] - m);
        if (F.tid < 64) { float o = 0.f;
            for (int i = 0; i < 387; ++i) { const float p = __builtin_amdgcn_exp2f(sc[i] - m); if (p > 0.f) { const int g = i / 129, j = i % 129, dil = (g == 0) ? 1 : (g == 1) ? 4 : 16;
                o += p * __builtin_bit_cast(float, (unsigned)A_QKV[((size_t)b * SEQ + t - j * dil) * NQKV + g * 3072 + 2048 + h * 64 + F.tid] << 16); } }
            o /= l;
            const float got = __builtin_bit_cast(float, (unsigned)A_O[row * D + h * 64 + F.tid] << 16);
            const float df = got - o; werr += (df == df) ? df * df : 1e6f; wref += o * o; }
        __syncthreads();
    }
    werr = wave_sum(werr); wref = wave_sum(wref);
    if (F.lane == 0) { atomicAdd((float*)(F.ctl + CW_DBG), werr); atomicAdd((float*)(F.ctl + CW_DBG + 1), wref); }
}
__device__ __forceinline__ void dbg_check_gla(Frame& F, const Args& A) {
    float werr = 0.f, wref = 0.f;
    if (blockIdx.x < 8) {
        const int b = blockIdx.x, hd = blockIdx.x & 3;
        LAS float* al = (LAS float*)(F.lds + RING_OFF); LAS float* qq = al + 128; LAS float* kk = qq + 128; LAS float* ov = kk + 128;
        float S[128];
#pragma unroll
        for (int d = 0; d < 128; ++d) S[d] = 0.f;
        for (int t = 0; t < 256; ++t) {
            const size_t row = (size_t)b * SEQ + t;
            if (F.tid < 128) { const int d = F.tid; float z = A_b_gb[hd * 128 + d];
                for (int j = 0; j < 16; ++j) z += A_APROJ[row * 16 + j] * A_b_wg[j * 512 + hd * 128 + d];
                const float sp = __builtin_fmaxf(-z, 0.f) + __logf(1.0f + __expf(-__builtin_fabsf(z)));
                al[d] = __expf(-sp / 16.0f);
                qq[d] = __builtin_bit_cast(float, (unsigned)A_PROJ[row * NPROJ + hd * 128 + d] << 16) * 0.08838834764831845f;
                kk[d] = __builtin_bit_cast(float, (unsigned)A_PROJ[row * NPROJ + 512 + hd * 128 + d] << 16); }
            __syncthreads();
            if (F.tid < 256) { const float v = __builtin_bit_cast(float, (unsigned)A_PROJ[row * NPROJ + 1024 + hd * 256 + F.tid] << 16); float o = 0.f;
#pragma unroll
                for (int d = 0; d < 128; ++d) { S[d] = al[d] * S[d] + kk[d] * v; o += qq[d] * S[d]; }
                ov[F.tid] = o; }
            __syncthreads();
            if (F.tid < 256) { float ss = 0.f; for (int i = 0; i < 256; ++i) ss += ov[i] * ov[i];
                const float rinv = 1.0f / sqrtf(ss / 256.0f + RMS_EPS);
                const float r = __builtin_bit_cast(float, (unsigned)A_PROJ[row * NPROJ + 2048 + hd * 256 + F.tid] << 16);
                const float ref = ov[F.tid] * rinv * A_b_og[F.tid] * (r / (1.0f + __expf(-r)));
                const float got = __builtin_bit_cast(float, (unsigned)A_O[row * D + hd * 256 + F.tid] << 16);
                const float df = got - ref; werr += (df == df) ? df * df : 1e6f; wref += ref * ref; }
            __syncthreads();
        }
    }
    werr = wave_sum(werr); wref = wave_sum(wref);
    if (F.lane == 0) { atomicAdd((float*)(F.ctl + CW_DBG), werr); atomicAdd((float*)(F.ctl + CW_DBG + 1), wref); }
}
#endif
enum Phase { P_PRO = 0, P_N1, P_QKV, P_ATT0, P_ATT1, P_ATT2, P_AOUT, P_R0, P_GU0, P_DN0, P_C0, P_BIN, P_GLA, P_BOUT, P_R1, P_GU1, P_DN1, P_C1, P_COUNT };

__global__ void __launch_bounds__(NWAVES * 64, 2) mk_fwd(Args args) {
    extern __shared__ __attribute__((aligned(16))) unsigned char lds_raw[];
    Frame F;
    F.lds = (LAS unsigned char*)lds_raw;
    F.MISC = (volatile LAS unsigned*)(F.lds + MISC_OFF);
    F.tid = threadIdx.x; F.lane = F.tid & 63; F.wave = __builtin_amdgcn_readfirstlane(F.tid >> 6); F.G = gridDim.x;
    const Args& A = args;
    F.ctl = (gu32*)(A.ws + WS_CTL);
    for (int u = F.tid; u < RING_OFF / 4; u += NWAVES * 64) ((LAS unsigned*)F.lds)[u] = 0u;
    __syncthreads();
    XcdBarrier bar; bar.bar = (unsigned*)(F.ctl + CW_BAR); bar.x = 0; bar.st = nullptr;
    if (!MK_PER_PHASE) bar = xcd_barrier_post((unsigned*)(F.ctl + CW_BAR), F.MISC + 8);
    const int lo = args.ph_lo, hi = args.ph_hi;
#ifndef ONLY_PHASE
#define ONLY_PHASE -1
#endif
#define IN(k) ((ONLY_PHASE < 0 || ONLY_PHASE == (k)) && lo <= (k) && (k) < hi && (k) <= MK_LAST_PHASE)
#define SEAM(k) do { if (!MK_PER_PHASE && (k) + 1 < hi) xcd_barrier(bar); } while (0)
    LAS unsigned char* ring = F.lds + RING_OFF; LAS unsigned* tab = (LAS unsigned*)(F.lds + TAB_OFF);
    float* const XB = A_out;

    if (IN(P_PRO)) { p0_prologue(F, A); SEAM(P_PRO); }
    if (IN(P_N1)) { p_norm1(F, A, A_x, 0); SEAM(P_N1); }
    if (IN(P_QKV)) {
        pg8::DenseSched S; S.init(A_H, A_WAIN, NTOK, NQKV, F.G, (int)blockIdx.x);
        pg8::EpiQKV E{A_QKV, A_pos, A_a_qg, A_a_kg};
        pg8::gemm_phase(ring, tab, S, E); SEAM(P_QKV);
    }
    if (IN(P_ATT0) && (MK_PROBE == 0 || MK_PROBE == 5 || MK_PROBE == 6)) { att::phase<0>(F, A); SEAM(P_ATT0); }
    if (IN(P_ATT1) && (MK_PROBE == 0 || MK_PROBE == 6)) { att::phase<1>(F, A); SEAM(P_ATT1); }
    if (IN(P_ATT2) && (MK_PROBE == 0)) { att::phase<2>(F, A); SEAM(P_ATT2); }
#if MK_CHECK == 3
    dbg_check_attn(F, A); xcd_barrier(bar);
#endif
    if (IN(P_AOUT)) {
        pg8::DenseSched S;
        if (MK_PROBE == 1) S.init(A_H, A_WAOUT, NTOK, D, F.G, (int)blockIdx.x);
        else if (MK_PROBE == 2) S.init(A_QKV + 2048, A_WAOUT, NTOK, D, F.G, (int)blockIdx.x, NQKV);
        else if (MK_PROBE == 3) S.init(A_QKV, A_WAOUT, NTOK, D, F.G, (int)blockIdx.x, NQKV);
        else if (MK_PROBE == 4) S.init(A_QKV + 1024, A_WAOUT, NTOK, D, F.G, (int)blockIdx.x, NQKV);
        else S.init(A_O, A_WAOUT, NTOK, D, F.G, (int)blockIdx.x);
        pg8::EpiResid E{A_x, A_XA, A_mod + 2 * 1024};
        pg8::gemm_phase(ring, tab, S, E); SEAM(P_AOUT);
    }
#if MK_CHECK == 1 || MK_CHECK == 2
#define DBG_MOE(L) if (MK_CHECK == (L) + 1) { dbg_check_moe(F, A, L); xcd_barrier(bar); }
#else
#define DBG_MOE(L)
#endif
#define MOE_LAYER(L, PR, PGU, PDN, XIN) \
    if (IN(PR)) { p_norm2_route(F, A, XIN, L); SEAM(PR); } \
    if (IN(PGU)) { const int n = moe_build_units(F, A, L, 8); \
        pg8::MoeSched<true> S{(const LAS int*)(F.lds + SEL_OFF), n, (const LAS int*)(F.lds + MISC_OFF) + 80, (const LAS int*)(F.lds + MISC_OFF) + 128, A_H, A_WGU + (size_t)(L) * 32 * 2048 * 1024, (size_t)2048 * 1024 * 2, A_TOKLIST}; \
        pg8::EpiGLU E{A_ACT, A_b_gu + (size_t)(L) * 32 * 2048, (const LAS int*)(F.lds + MISC_OFF) + 80}; \
        pg8::gemm_phase(ring, tab, S, E); SEAM(PGU); } \
    if (IN(PDN)) { const int n = moe_build_units(F, A, L, 4); \
        pg8::MoeSched<false> S{(const LAS int*)(F.lds + SEL_OFF), n, (const LAS int*)(F.lds + MISC_OFF) + 80, (const LAS int*)(F.lds + MISC_OFF) + 128, A_ACT, A_WDN + (size_t)(L) * 32 * 1024 * 1024, (size_t)1024 * 1024 * 2, A_TOKLIST}; \
        pg8::EpiDown E{A_Y, A_b_dn + (size_t)(L) * 32 * 1024, A_GATEW}; \
        pg8::gemm_phase(ring, tab, S, E); SEAM(PDN); DBG_MOE(L) }
    MOE_LAYER(0, P_R0, P_GU0, P_DN0, A_XA)
    if (IN(P_C0)) { p_combine<true>(F, A, A_XA, XB, 0); SEAM(P_C0); }
    if (IN(P_BIN)) {
        pg8::DenseSched S; S.init(A_H, A_WBIN, NTOK, NPROJ, F.G, (int)blockIdx.x);
        pg8::EpiBf16Plain E{A_PROJ, NPROJ};
        pg8::gemm_phase(ring, tab, S, E); SEAM(P_BIN);
    }
    if (IN(P_GLA)) { gla::phase(F, A); SEAM(P_GLA); }
#if MK_CHECK == 4
    dbg_check_gla(F, A); xcd_barrier(bar);
#endif
    if (IN(P_BOUT)) {
        pg8::DenseSched S; S.init(A_O, A_WBOUT, NTOK, D, F.G, (int)blockIdx.x);
        pg8::EpiResid E{XB, A_XA, A_mod + 8 * 6144 + 2 * 1024};
        pg8::gemm_phase(ring, tab, S, E); SEAM(P_BOUT);
    }
    MOE_LAYER(1, P_R1, P_GU1, P_DN1, A_XA)
    if (IN(P_C1)) { p_combine<false>(F, A, A_XA, A_out, 1); }
#if MK_CHECK
    { xcd_barrier(bar); const float e2 = __builtin_bit_cast(float, __hip_atomic_load((unsigned*)(F.ctl + CW_DBG), RLX_AGENT)), r2 = __builtin_bit_cast(float, __hip_atomic_load((unsigned*)(F.ctl + CW_DBG + 1), RLX_AGENT));
      const float dv = __builtin_fminf(MK_CHECK_GAIN * sqrtf(e2 / (r2 + 1e-30f)), 4.0f);
      for (size_t i = (size_t)blockIdx.x * 512 + F.tid; i < (size_t)NTOK * D / 4; i += (size_t)F.G * 512) { f32x4 v = ((f32x4*)A_out)[i]; v = v + dv; ((f32x4*)A_out)[i] = v; } }
#endif
#if MK_LAST_PHASE < 99
    if (hi == P_COUNT) {
        if (!MK_PER_PHASE) xcd_barrier(bar);
        const float* src = (MK_LAST_PHASE < P_AOUT) ? A_x : (MK_LAST_PHASE < P_C0) ? A_XA : (MK_LAST_PHASE < P_BOUT) ? (const float*)nullptr : A_XA;
        if (src) for (size_t i = (size_t)blockIdx.x * 512 + F.tid; i < (size_t)NTOK * D / 4; i += (size_t)F.G * 512) ((f32x4*)A_out)[i] = ((const f32x4*)src)[i];
    }
#endif
#undef IN
#undef SEAM
}

extern "C" void kernel_launch(void* const* d_in, const int* in_sizes, int n_in, void* d_out, int out_size, void* d_ws, size_t ws_size, hipStream_t stream) {
    static int grid = 0;
    if (grid == 0) {
        if (n_in != 22 || out_size != NTOK * D || ws_size < WS_END) { fprintf(stderr, "kernel_launch: unexpected shapes (n_in %d, out %d, ws %zu < %zu)\n", n_in, out_size, ws_size, (size_t)WS_END); grid = -1; return; }
        int dev = 0, cus = 0, per_cu = 0;
        if (hipGetDevice(&dev) != hipSuccess || hipDeviceGetAttribute(&cus, hipDeviceAttributeMultiprocessorCount, dev) != hipSuccess) { grid = -1; return; }
        if (hipFuncSetAttribute((const void*)mk_fwd, hipFuncAttributeMaxDynamicSharedMemorySize, LDS_BYTES) != hipSuccess) { fprintf(stderr, "kernel_launch: hipFuncSetAttribute failed\n"); grid = -1; return; }
        if (hipOccupancyMaxActiveBlocksPerMultiprocessor(&per_cu, (const void*)mk_fwd, NWAVES * 64, LDS_BYTES) != hipSuccess || per_cu < 1) { fprintf(stderr, "kernel_launch: occupancy query says %d\n", per_cu); }
        (void)hipGetLastError();
        grid = cus;
    }
    if (grid < 0) return;
    if (hipMemsetAsync((char*)d_ws + WS_CTL, 0, CTL_ZERO_BYTES, stream) != hipSuccess) return;
    Args a{};
    for (int i = 0; i < 22; ++i) a.in[i] = d_in[i];
    a.out = (float*)d_out; a.ws = (unsigned char*)d_ws;
#if MK_PER_PHASE
    for (int p = 0; p < P_COUNT; ++p) { a.ph_lo = p; a.ph_hi = p + 1; hipLaunchKernelGGL(mk_fwd, dim3(grid), dim3(NWAVES * 64), LDS_BYTES, stream, a); }
#else
    a.ph_lo = 0; a.ph_hi = P_COUNT;
    hipLaunchKernelGGL(mk_fwd, dim3(grid), dim3(NWAVES * 64), LDS_BYTES, stream, a);
#endif
    const hipError_t le = hipPeekAtLastError();
    if (le != hipSuccess) fprintf(stderr, "kernel_launch: launch failed: %s\n", hipGetErrorName(le));
}
```

```cpp
#include <hip/hip_runtime.h>
#include <cstdio>
#include <cstdint>

#define LAS __attribute__((address_space(3)))
#define GAS __attribute__((address_space(1)))
typedef unsigned short bf16_t;
typedef short bf16x8 __attribute__((ext_vector_type(8)));
typedef short s16x4 __attribute__((ext_vector_type(4)));
typedef float f32x2 __attribute__((ext_vector_type(2)));
typedef float f32x4 __attribute__((ext_vector_type(4)));
typedef float f32x16 __attribute__((ext_vector_type(16)));
typedef unsigned u32x2 __attribute__((ext_vector_type(2)));
typedef unsigned u32x4 __attribute__((ext_vector_type(4)));
typedef GAS unsigned gu32;

#ifndef MK_PER_PHASE
#define MK_PER_PHASE 0
#endif
#ifndef MK_CHECK
#define MK_CHECK 0
#endif
#ifndef MK_CHECK_GAIN
#define MK_CHECK_GAIN 10.0f
#endif
#ifndef MK_DUP
#define MK_DUP 0u
#endif
#ifndef MK_PROBE
#define MK_PROBE 0
#endif
#ifndef MK_LAST_PHASE
#define MK_LAST_PHASE 99
#endif

constexpr int D = 1024, NB = 8, SEQ = 4096, NTOK = NB * SEQ;
constexpr int NQKV = 9216, NPROJ = 3072, BIN_PITCH = 3088;
constexpr int NE = 32, TOPK = 4, NASSIGN = NTOK * TOPK, ECAP = NTOK;
constexpr int ACT_ROWS = NASSIGN + NE * 256;
constexpr float RMS_EPS = 1e-6f;
constexpr float LOG2E = 1.4426950408889634f;

constexpr size_t MiB = 1u << 20;
constexpr size_t WS_CTL = 0, CTL_ZERO_BYTES = 1 * MiB;
constexpr size_t WS_MOD = 1 * MiB;
constexpr size_t WS_WAIN = 2 * MiB;
constexpr size_t WS_WAOUT = 20 * MiB;
constexpr size_t WS_WBIN = 22 * MiB;
constexpr size_t WS_WBOUT = 28 * MiB;
constexpr size_t WS_WTR = 30 * MiB;
constexpr size_t WS_WTA = 30 * MiB + 512 * 1024;
constexpr size_t WS_WGU = 32 * MiB;
constexpr size_t WS_WDN = 288 * MiB;
constexpr size_t WS_H = 416 * MiB;
constexpr size_t WS_O = 480 * MiB;
constexpr size_t WS_LSE = 544 * MiB;
constexpr size_t WS_APROJ = 546 * MiB;
constexpr size_t WS_GATEW = 548 * MiB;
constexpr size_t WS_TOKLIST = 549 * MiB;
constexpr size_t WS_XA = 556 * MiB;
constexpr size_t WS_R = 684 * MiB;
constexpr size_t WS_ACT = WS_R;
constexpr size_t WS_Y = WS_R + 272 * MiB;
constexpr size_t WS_END = WS_R + 576 * MiB;
constexpr size_t WS_GS = WS_END + 4 * MiB;
constexpr size_t WS_GD = WS_GS + 32 * MiB;
constexpr size_t WS_END2 = WS_GD + 1 * MiB;
constexpr size_t WS_DBG = WS_END;
static_assert((size_t)ACT_ROWS * 2048 <= 272 * MiB && (size_t)NASSIGN * 2048 <= 304 * MiB, "ws map");
constexpr int CW_TMO = 0, CW_CODE = 1, CW_DBG = 64, CW_BAR = 4096, CW_CNT = 8192;

constexpr int MISC_OFF = 0;
constexpr int TAB_OFF = 1024;
constexpr int SEL_OFF = 4096;
constexpr int RING_OFF = 8192;
constexpr int LDS_BYTES = 147456;

#define RLX_AGENT __ATOMIC_RELAXED, __HIP_MEMORY_SCOPE_AGENT
#define LDS_WAIT() asm volatile("s_waitcnt lgkmcnt(0)" ::: "memory")
#define VM_WAIT() asm volatile("s_waitcnt vmcnt(0)" ::: "memory")
__device__ __forceinline__ unsigned f2bf(float f) { unsigned u = __builtin_bit_cast(unsigned, f); return (u + 0x7fffu + ((u >> 16) & 1u)) >> 16; }
__device__ __forceinline__ unsigned pk2(float lo, float hi) { return f2bf(lo) | (f2bf(hi) << 16); }
typedef __bf16 bf16x2_t __attribute__((ext_vector_type(2)));
__device__ __forceinline__ unsigned cvt_pk_bf16(float lo, float hi) { const f32x2 v = {lo, hi}; const bf16x2_t b = __builtin_convertvector(v, bf16x2_t); return __builtin_bit_cast(unsigned, b); }
__device__ __forceinline__ float bflo(unsigned w) { return __builtin_bit_cast(float, w << 16); }
__device__ __forceinline__ float bfhi(unsigned w) { return __builtin_bit_cast(float, w & 0xffff0000u); }
__device__ __forceinline__ float wave_sum(float v) {
#pragma unroll
    for (int o = 1; o < 64; o <<= 1) v += __shfl_xor(v, o);
    return v;
}
__device__ __forceinline__ int crow(int r, int hi) { return (r & 3) + 8 * (r >> 2) + 4 * hi; }
__device__ __forceinline__ s16x4 tr_read(LAS const char* p) { typedef short v4i16_t __attribute__((ext_vector_type(4))); return __builtin_bit_cast(s16x4, __builtin_amdgcn_ds_read_tr16_b64_v4i16((LAS v4i16_t*)p)); }
#define CAT8(lo, hi) ((bf16x8){lo[0], lo[1], lo[2], lo[3], hi[0], hi[1], hi[2], hi[3]})

namespace pg8 {
constexpr int BM = 256, BK = 64, HALF = 128, HTB = HALF * BK * 2, STAGE_BYTES = 8 * HTB, KD = 1024, NT = KD / BK;
__host__ __device__ __forceinline__ int lds_byte(int r, int c) { const int st = (r >> 4) * 2 + (c >> 5), rr = r & 15, cc = c & 31, ob = rr * 64 + cc * 2; return st * 1024 + (ob ^ (((ob >> 9) & 1) << 5)); }
__host__ __device__ __forceinline__ void stage_rc(int b, int& R, int& C) { const int st = b / 1024, sb = b % 1024, swz = sb ^ (((sb >> 9) & 1) << 5); R = (st >> 1) * 16 + swz / 64; C = (st & 1) * 32 + (swz % 64) / 2; }

struct GUnit { int e, pm, pn, rows; };
typedef f32x4 Acc[2][2][4][2];

template <class Epi, class Sched>
__device__ __forceinline__ void gemm_phase(LAS unsigned char* lds, LAS unsigned* tab, const Sched& S, const Epi& E) {
    const int tid = threadIdx.x, wid = __builtin_amdgcn_readfirstlane(tid >> 6), lane = tid & 63, wr = wid >> 2, wc = wid & 3, fr = lane & 15, fq = lane >> 4;
    int sR[2], sC[2]; unsigned voffB[2];
#pragma unroll
    for (int i = 0; i < 2; ++i) { stage_rc(tid * 16 + i * 8192, sR[i], sC[i]); voffB[i] = (unsigned)(sR[i] * KD + sC[i]) * 2u; }
    constexpr unsigned kstep = BK * 2;
    constexpr size_t hstepB = (size_t)HALF * KD * 2;
    const unsigned ldsw = (unsigned)wid * 1024u;
    const int aoff = lds_byte(wr * 64 + fr, fq * 8), boff = lds_byte(wc * 32 + fr, fq * 8);
    const char* const Ab = S.abase();
#define PG8_SA(b, h) (((b) * 2 + (h)) * HTB)
#define PG8_SB(b, h) ((4 + (b) * 2 + (h)) * HTB)
#define PG8_STAGE_B(bufoff, gbase) do { _Pragma("unroll") for (int _i = 0; _i < 2; ++_i) \
        __builtin_amdgcn_global_load_lds((const unsigned*)((const char*)(gbase) + voffB[_i]), (LAS unsigned*)(lds + (bufoff) + ldsw + _i * 8192), 16, 0, 0); } while (0)
#define PG8_STAGE_A(bufoff, uah, koff) do { _Pragma("unroll") for (int _i = 0; _i < 2; ++_i) \
        __builtin_amdgcn_global_load_lds((const unsigned*)(Ab + (size_t)((uah)[_i]) + (size_t)(koff)), (LAS unsigned*)(lds + (bufoff) + ldsw + _i * 8192), 16, 0, 0); } while (0)
#define PG8_LDA(dst, b, h) do { _Pragma("unroll") for (int m = 0; m < 4; ++m) _Pragma("unroll") for (int k = 0; k < 2; ++k) dst[m][k] = *(const LAS bf16x8*)(lds + PG8_SA(b, h) + aoff + m * 2048 + k * 1024); } while (0)
#define PG8_LDB(dst, b, h) do { _Pragma("unroll") for (int n = 0; n < 2; ++n) _Pragma("unroll") for (int k = 0; k < 2; ++k) dst[n][k] = *(const LAS bf16x8*)(lds + PG8_SB(b, h) + boff + n * 2048 + k * 1024); } while (0)
#define PG8_MMA(ai, bj, At, Bt) do { __builtin_amdgcn_s_setprio(1); _Pragma("unroll") for (int m = 0; m < 4; ++m) _Pragma("unroll") for (int n = 0; n < 2; ++n) _Pragma("unroll") for (int k = 0; k < 2; ++k) \
        acc[ai][bj][m][n] = __builtin_amdgcn_mfma_f32_16x16x32_bf16(Bt[n][k], At[m][k], acc[ai][bj][m][n], 0, 0, 0); __builtin_amdgcn_s_setprio(0); } while (0)
#define PG8_WAIT_V(n) asm volatile("s_waitcnt vmcnt(" #n ")" ::: "memory")
#define PG8_WAIT_L(n) asm volatile("s_waitcnt lgkmcnt(" #n ")" ::: "memory")
#define PG8_BAR __builtin_amdgcn_s_barrier()
#define PG8_SCHED __builtin_amdgcn_sched_barrier(0)
    GUnit cur, nxt; int ui = 0;
    if (!S.next(0, cur)) return;
    Acc acc;
#pragma unroll
    for (int a = 0; a < 2; ++a)
#pragma unroll
        for (int b = 0; b < 2; ++b)
#pragma unroll
            for (int m = 0; m < 4; ++m)
#pragma unroll
                for (int n = 0; n < 2; ++n) acc[a][b][m][n] = (f32x4){0.f, 0.f, 0.f, 0.f};
    bf16x8 At[4][2], B0[2][2], B1[2][2];
    unsigned uaC[2][2], uaN[2][2];
    if constexpr (Sched::TAB) { S.issue_tab(cur, tab, wid, lane); PG8_WAIT_V(0); __syncthreads(); }
    S.aoffs(cur, tab, sR, sC, uaC);
    const char* cB = S.bbase(cur);
    PG8_STAGE_B(PG8_SB(0, 0), cB); PG8_STAGE_B(PG8_SB(0, 1), cB + hstepB); PG8_STAGE_A(PG8_SA(0, 0), uaC[0], 0); PG8_STAGE_A(PG8_SA(0, 1), uaC[1], 0);
    if (wr == 1) PG8_BAR;
    PG8_WAIT_V(2); PG8_BAR;
    PG8_STAGE_B(PG8_SB(1, 0), cB + kstep); PG8_STAGE_A(PG8_SA(1, 0), uaC[0], kstep); PG8_STAGE_B(PG8_SB(1, 1), cB + hstepB + kstep);
    PG8_WAIT_V(6); PG8_BAR;
    for (;;) {
        const bool has_next = S.next(ui + 1, nxt);
        LAS unsigned* const tabN = tab + ((ui + 1) % 3) * 256;
        if constexpr (Sched::TAB) { if (has_next) S.issue_tab(nxt, tabN, wid, lane); }
        const char* nB = has_next ? S.bbase(nxt) : cB;
        for (int t = 0; t < NT; t += 2) {
            const bool last = (t == NT - 2);
            if (last) { if (has_next) S.aoffs(nxt, tabN, sR, sC, uaN); else {
#pragma unroll
                for (int h = 0; h < 2; ++h)
#pragma unroll
                    for (int i = 0; i < 2; ++i) uaN[h][i] = uaC[h][i]; } }
            unsigned u2[2][2];
#pragma unroll
            for (int h = 0; h < 2; ++h)
#pragma unroll
                for (int i = 0; i < 2; ++i) u2[h][i] = last ? uaN[h][i] : uaC[h][i];
            const unsigned k1 = (unsigned)(t + 1) * kstep, k2 = last ? 0u : (unsigned)(t + 2) * kstep;
            const char* b2 = last ? nB : cB + (size_t)(t + 2) * kstep; const char* b3 = b2 + kstep;
            PG8_LDB(B0, 0, 0); PG8_LDB(B1, 0, 1); PG8_SCHED; PG8_LDA(At, 0, 0); PG8_STAGE_A(PG8_SA(1, 1), uaC[1], k1);
            PG8_WAIT_V(8); PG8_WAIT_L(0); PG8_BAR; PG8_MMA(0, 0, At, B0); PG8_MMA(0, 1, At, B1); PG8_BAR; PG8_SCHED;
            PG8_LDA(At, 0, 1); PG8_STAGE_B(PG8_SB(0, 0), b2); PG8_STAGE_B(PG8_SB(0, 1), b2 + hstepB); PG8_STAGE_A(PG8_SA(0, 0), u2[0], k2);
            PG8_WAIT_V(8); PG8_WAIT_L(0); PG8_BAR; PG8_MMA(1, 0, At, B0); PG8_MMA(1, 1, At, B1); PG8_BAR; PG8_SCHED;
            PG8_LDB(B0, 1, 0); PG8_LDB(B1, 1, 1); PG8_SCHED; PG8_LDA(At, 1, 0); PG8_STAGE_A(PG8_SA(0, 1), u2[1], k2);
            PG8_WAIT_V(8); PG8_WAIT_L(0); PG8_BAR; PG8_MMA(0, 0, At, B0); PG8_MMA(0, 1, At, B1); PG8_BAR; PG8_SCHED;
            PG8_LDA(At, 1, 1); PG8_STAGE_B(PG8_SB(1, 0), b3); PG8_STAGE_B(PG8_SB(1, 1), b3 + hstepB); PG8_STAGE_A(PG8_SA(1, 0), u2[0], k2 + kstep);
            PG8_WAIT_V(8); PG8_WAIT_L(0); PG8_BAR; PG8_MMA(1, 0, At, B0); PG8_MMA(1, 1, At, B1); PG8_BAR; PG8_SCHED;
        }
        if (wr == 0) PG8_BAR;
        E(acc, cur, wr, wc, fr, fq, tab + (ui % 3) * 256);
        if (!has_next) break;
#pragma unroll
        for (int a = 0; a < 2; ++a)
#pragma unroll
            for (int b = 0; b < 2; ++b)
#pragma unroll
                for (int m = 0; m < 4; ++m)
#pragma unroll
                    for (int n = 0; n < 2; ++n) acc[a][b][m][n] = (f32x4){0.f, 0.f, 0.f, 0.f};
        cur = nxt; cB = nB; ++ui;
#pragma unroll
        for (int h = 0; h < 2; ++h)
#pragma unroll
            for (int i = 0; i < 2; ++i) uaC[h][i] = uaN[h][i];
        if (wr == 1) PG8_BAR;
    }
    PG8_WAIT_V(0);
    PG8_BAR;
#undef PG8_SA
#undef PG8_SB
#undef PG8_STAGE_A
#undef PG8_STAGE_B
#undef PG8_LDA
#undef PG8_LDB
#undef PG8_MMA
#undef PG8_WAIT_V
#undef PG8_WAIT_L
#undef PG8_BAR
#undef PG8_SCHED
}

constexpr int NXCD = 8, WGM = 8;
struct DenseSched {
    static constexpr bool TAB = false;
    const bf16_t* A; const bf16_t* Bt; int nM, nN, nwg, G, c, lda;
    __device__ __forceinline__ void init(const bf16_t* A_, const bf16_t* Bt_, int M, int N, int G_, int c_, int lda_ = KD) { A = A_; Bt = Bt_; nM = M / BM; nN = N / BM; nwg = nM * nN; G = G_; c = c_; lda = lda_; }
    __device__ __forceinline__ bool next(int i, GUnit& u) const {
        const long L = (long)i * G + c; if (L >= nwg) return false;
        int wgid = (int)L; { const int q = nwg / NXCD, r = nwg % NXCD, xcd = wgid % NXCD, off = wgid / NXCD; wgid = (xcd < r ? xcd * (q + 1) : r * (q + 1) + (xcd - r) * q) + off; }
        const int nig = WGM * nN, gid = wgid / nig, fm = gid * WGM, gsz = (nM - fm) < WGM ? (nM - fm) : WGM;
        u.pm = fm + ((wgid % nig) % gsz); u.pn = (wgid % nig) / gsz; u.e = 0; u.rows = 256; return true;
    }
    __device__ __forceinline__ const char* abase() const { return (const char*)A; }
    __device__ __forceinline__ const char* bbase(const GUnit& u) const { return (const char*)Bt + (size_t)u.pn * (BM * KD * 2); }
    __device__ __forceinline__ void issue_tab(const GUnit&, LAS unsigned*, int, int) const {}
    __device__ __forceinline__ void aoffs(const GUnit& u, LAS unsigned*, const int (&sR)[2], const int (&sC)[2], unsigned (&ua)[2][2]) const {
#pragma unroll
        for (int h = 0; h < 2; ++h)
#pragma unroll
            for (int i = 0; i < 2; ++i) ua[h][i] = (unsigned)((u.pm * BM + h * HALF + sR[i]) * lda + sC[i]) * 2u;
    }
};
template <bool GATHER> struct MoeSched {
    static constexpr bool TAB = true;
    const LAS int* ulist; int nunits; const LAS int* tstart; const LAS int* ecnt;
    const bf16_t* A; const bf16_t* Wt; size_t wstride; const unsigned* toklist;
    __device__ __forceinline__ bool next(int i, GUnit& u) const {
        if (i >= nunits) return false; const int v = ulist[i]; u.e = v & 255; u.pm = (v >> 8) & 4095; u.pn = v >> 20;
        const int rem = ecnt[u.e] - u.pm * 256; u.rows = rem < 256 ? rem : 256; return true;
    }
    __device__ __forceinline__ const char* abase() const { return (const char*)A; }
    __device__ __forceinline__ const char* bbase(const GUnit& u) const { return (const char*)Wt + (size_t)u.e * wstride + (size_t)u.pn * (BM * KD * 2); }
    __device__ __forceinline__ void issue_tab(const GUnit& u, LAS unsigned* t, int wid, int lane) const {
        if (wid < 4) __builtin_amdgcn_global_load_lds((const unsigned*)(toklist + (size_t)u.e * ECAP + u.pm * 256 + wid * 64 + lane), (LAS unsigned*)(t + wid * 64), 4, 0, 0);
    }
    __device__ __forceinline__ void aoffs(const GUnit& u, LAS unsigned* t, const int (&sR)[2], const int (&sC)[2], unsigned (&ua)[2][2]) const {
#pragma unroll
        for (int h = 0; h < 2; ++h)
#pragma unroll
            for (int i = 0; i < 2; ++i) {
                const int r = h * HALF + sR[i];
                if constexpr (GATHER) { const unsigned s = t[r < u.rows ? r : 0]; ua[h][i] = (s >> 2) * (unsigned)(KD * 2) + (unsigned)sC[i] * 2u; }
                else ua[h][i] = (unsigned)(((tstart[u.e] + u.pm) * BM + r) * KD + sC[i]) * 2u;
            }
    }
};

struct EpiBf16Plain {
    bf16_t* O; int ldc;
    __device__ __forceinline__ void operator()(const Acc& acc, const GUnit& u, int wr, int wc, int fr, int fq, LAS unsigned*) const {
        const int row0 = u.pm * BM + wr * 64 + fr, col0 = u.pn * BM + wc * 64 + fq * 8;
#pragma unroll
        for (int ai = 0; ai < 2; ++ai)
#pragma unroll
            for (int m = 0; m < 4; ++m) { bf16_t* rowp = O + (size_t)(row0 + ai * HALF + m * 16) * ldc + col0;
#pragma unroll
                for (int bj = 0; bj < 2; ++bj) { const f32x4 v0 = acc[ai][bj][m][0], v1 = acc[ai][bj][m][1];
                    u32x4 w; w.x = cvt_pk_bf16(v0[0], v0[1]); w.y = cvt_pk_bf16(v0[2], v0[3]); w.z = cvt_pk_bf16(v1[0], v1[1]); w.w = cvt_pk_bf16(v1[2], v1[3]);
                    *(u32x4*)(rowp + bj * 32) = w; } }
    }
};
struct EpiQKV {
    bf16_t* O; const int* pos; const float* qg; const float* kg;
    __device__ __forceinline__ void operator()(const Acc& acc, const GUnit& u, int wr, int wc, int fr, int fq, LAS unsigned*) const {
        const int g = u.pn / 12, s = (u.pn % 12) >> 2;
        const int row0 = u.pm * BM + wr * 64 + fr, col0 = u.pn * BM + wc * 64 + fq * 8;
        if (s == 2) {
#pragma unroll
            for (int ai = 0; ai < 2; ++ai)
#pragma unroll
                for (int m = 0; m < 4; ++m) { bf16_t* rowp = O + (size_t)(row0 + ai * HALF + m * 16) * NQKV + col0;
#pragma unroll
                    for (int bj = 0; bj < 2; ++bj) { const f32x4 v0 = acc[ai][bj][m][0], v1 = acc[ai][bj][m][1];
                        u32x4 w; w.x = cvt_pk_bf16(v0[0], v0[1]); w.y = cvt_pk_bf16(v0[2], v0[3]); w.z = cvt_pk_bf16(v1[0], v1[1]); w.w = cvt_pk_bf16(v1[2], v1[3]);
                        *(u32x4*)(rowp + bj * 32) = w; } }
            return;
        }
        const float* gain = (s == 0 ? qg : kg) + g * 64; const float sc = (s == 0) ? 0.125f * LOG2E : 1.0f;
#pragma unroll
        for (int ai = 0; ai < 2; ++ai)
#pragma unroll
            for (int m = 0; m < 4; ++m) {
                const int row = row0 + ai * HALF + m * 16; const float p = (float)pos[row];
                int gofs = 8 * fq; asm volatile("" : "+v"(gofs));
                const f32x4 ga = *(const f32x4*)(gain + gofs), gb = *(const f32x4*)(gain + gofs + 4), gc = *(const f32x4*)(gain + gofs + 32), gd = *(const f32x4*)(gain + gofs + 36);
                float v1[8], v2[8]; float ss = 0.f;
#pragma unroll
                for (int n = 0; n < 2; ++n)
#pragma unroll
                    for (int j = 0; j < 4; ++j) { v1[4 * n + j] = acc[ai][0][m][n][j]; v2[4 * n + j] = acc[ai][1][m][n][j]; ss += v1[4 * n + j] * v1[4 * n + j] + v2[4 * n + j] * v2[4 * n + j]; }
                ss += __shfl_xor(ss, 16); ss += __shfl_xor(ss, 32);
                const float rinv = __builtin_amdgcn_rsqf(ss * (1.0f / 64.0f) + RMS_EPS) * sc;
                float o1[8], o2[8];
#pragma unroll
                for (int i = 0; i < 8; ++i) { const float t1 = v1[i] * rinv * (i < 4 ? ga[i & 3] : gb[i & 3]), t2 = v2[i] * rinv * (i < 4 ? gc[i & 3] : gd[i & 3]);
                    const float invf = __builtin_amdgcn_exp2f(-(float)(gofs + i) * (13.287712379549449f / 32.0f)) * 0.15915494309189535f;
                    const float rev = __builtin_amdgcn_fractf(p * invf); const float cs = __builtin_amdgcn_cosf(rev), sn = __builtin_amdgcn_sinf(rev);
                    o1[i] = t1 * cs - t2 * sn; o2[i] = t2 * cs + t1 * sn; }
                bf16_t* rowp = O + (size_t)row * NQKV + col0;
                u32x4 w; w.x = cvt_pk_bf16(o1[0], o1[1]); w.y = cvt_pk_bf16(o1[2], o1[3]); w.z = cvt_pk_bf16(o1[4], o1[5]); w.w = cvt_pk_bf16(o1[6], o1[7]);
                *(u32x4*)(rowp) = w;
                w.x = cvt_pk_bf16(o2[0], o2[1]); w.y = cvt_pk_bf16(o2[2], o2[3]); w.z = cvt_pk_bf16(o2[4], o2[5]); w.w = cvt_pk_bf16(o2[6], o2[7]);
                *(u32x4*)(rowp + 32) = w;
                __builtin_amdgcn_sched_barrier(0);
            }
    }
};
struct EpiResid {
    const float* Xi; float* Xo; const float* gate;
    __device__ __forceinline__ void operator()(const Acc& acc, const GUnit& u, int wr, int wc, int fr, int fq, LAS unsigned*) const {
        const int row0 = u.pm * BM + wr * 64 + fr, col0 = u.pn * BM + wc * 32 + 4 * fq;
        const float* gp = gate + (size_t)((u.pm * BM) / SEQ) * 6144 + col0;
        f32x4 gv[2][2];
#pragma unroll
        for (int bj = 0; bj < 2; ++bj)
#pragma unroll
            for (int n = 0; n < 2; ++n) gv[bj][n] = *(const f32x4*)(gp + bj * HALF + n * 16);
#pragma unroll
        for (int ai = 0; ai < 2; ++ai)
#pragma unroll
            for (int m = 0; m < 4; ++m) { const size_t off = (size_t)(row0 + ai * HALF + m * 16) * D + col0;
#pragma unroll
                for (int bj = 0; bj < 2; ++bj)
#pragma unroll
                    for (int n = 0; n < 2; ++n) { const f32x4 xi = *(const f32x4*)(Xi + off + bj * HALF + n * 16); *(f32x4*)(Xo + off + bj * HALF + n * 16) = xi + gv[bj][n] * acc[ai][bj][m][n]; }
                asm volatile("" ::: "memory"); }
    }
};
struct EpiGLU {
    bf16_t* ACT; const float* bias; const LAS int* tstart;
    __device__ __forceinline__ void operator()(const Acc& acc, const GUnit& u, int wr, int wc, int fr, int fq, LAS unsigned*) const {
        const int c0 = u.pn * 128 + wc * 32 + fq * 8; const float* bp = bias + (size_t)u.e * 2048 + c0;
        const f32x4 bg0 = *(const f32x4*)(bp), bg1 = *(const f32x4*)(bp + 4), bu0 = *(const f32x4*)(bp + 1024), bu1 = *(const f32x4*)(bp + 1028);
        const size_t arow0 = (size_t)(tstart[u.e] + u.pm) * BM + wr * 64 + fr;
#pragma unroll
        for (int ai = 0; ai < 2; ++ai)
#pragma unroll
            for (int m = 0; m < 4; ++m) {
                const f32x4 ga = acc[ai][0][m][0] + bg0, gb = acc[ai][0][m][1] + bg1, ua = acc[ai][1][m][0] + bu0, ub = acc[ai][1][m][1] + bu1;
                float o[8];
#pragma unroll
                for (int j = 0; j < 4; ++j) {
                    { const float gt = __builtin_fminf(ga[j], 7.0f), up = __builtin_fminf(__builtin_fmaxf(ua[j], -7.0f), 7.0f);
                      const float sg = __builtin_amdgcn_rcpf(1.0f + __builtin_amdgcn_exp2f(-1.702f * LOG2E * gt)); o[j] = (up + 1.0f) * (gt * sg); }
                    { const float gt = __builtin_fminf(gb[j], 7.0f), up = __builtin_fminf(__builtin_fmaxf(ub[j], -7.0f), 7.0f);
                      const float sg = __builtin_amdgcn_rcpf(1.0f + __builtin_amdgcn_exp2f(-1.702f * LOG2E * gt)); o[4 + j] = (up + 1.0f) * (gt * sg); }
                }
                u32x4 w; w.x = cvt_pk_bf16(o[0], o[1]); w.y = cvt_pk_bf16(o[2], o[3]); w.z = cvt_pk_bf16(o[4], o[5]); w.w = cvt_pk_bf16(o[6], o[7]);
                *(u32x4*)(ACT + (arow0 + ai * HALF + m * 16) * D + c0) = w;
            }
    }
};
struct EpiDown {
    bf16_t* Y; const float* bias; const float* gatew;
    __device__ __forceinline__ void operator()(const Acc& acc, const GUnit& u, int wr, int wc, int fr, int fq, LAS unsigned* tab) const {
        const int col0 = u.pn * BM + wc * 64 + fq * 8; const float* bp = bias + (size_t)u.e * D + col0;
        f32x4 bv[2][2];
#pragma unroll
        for (int bj = 0; bj < 2; ++bj)
#pragma unroll
            for (int n = 0; n < 2; ++n) bv[bj][n] = *(const f32x4*)(bp + bj * 32 + n * 4);
#pragma unroll
        for (int ai = 0; ai < 2; ++ai)
#pragma unroll
            for (int m = 0; m < 4; ++m) {
                const int r = ai * HALF + wr * 64 + m * 16 + fr;
                if (r < u.rows) {
                    const unsigned slot = tab[r]; const float w = gatew[slot]; bf16_t* rowp = Y + (size_t)slot * D + col0;
#pragma unroll
                    for (int bj = 0; bj < 2; ++bj) { const f32x4 v0 = (acc[ai][bj][m][0] + bv[bj][0]) * w, v1 = (acc[ai][bj][m][1] + bv[bj][1]) * w;
                        u32x4 o; o.x = cvt_pk_bf16(v0[0], v0[1]); o.y = cvt_pk_bf16(v0[2], v0[3]); o.z = cvt_pk_bf16(v1[0], v1[1]); o.w = cvt_pk_bf16(v1[2], v1[3]);
                        *(u32x4*)(rowp + bj * 32) = o; }
                }
            }
    }
};
}

#define XB_TMO      128
#define XB_XCNT(j)  (256  + 64 * (j))
#define XB_XSUB(j)  (1280 + 64 * (j))
#define XB_XGEN(j)  (2304 + 64 * (j))
#define XB_TOP      3328
#define XB_TOPGEN   3392
#define XCD_BAR_WORDS 3456
#define XB_SPIN_CAP (1u << 18)
__device__ __forceinline__ unsigned xb_ld(unsigned* p)              { return __hip_atomic_load(p, __ATOMIC_RELAXED, __HIP_MEMORY_SCOPE_AGENT); }
__device__ __forceinline__ unsigned xb_add(unsigned* p, unsigned v) { return __hip_atomic_fetch_add(p, v, __ATOMIC_RELAXED, __HIP_MEMORY_SCOPE_AGENT); }
__device__ __forceinline__ unsigned xb_xcc_id() { return (unsigned)__builtin_amdgcn_s_getreg((3 << 11) | 20) & 0xFu; }
#define XB_SPIN(cond, bar) do { unsigned _sp = 0; while (cond) { __builtin_amdgcn_s_sleep(1); \
    if ((++_sp & 255u) == 0u) { if (xb_ld(&(bar)[XB_TMO])) break; if (_sp > XB_SPIN_CAP) { atomicAdd(&(bar)[XB_TMO], 1u); break; } } } } while (0)
struct XcdBarrier { unsigned* bar; unsigned x; volatile LAS unsigned* st; };
__device__ __forceinline__ XcdBarrier xcd_barrier_post(unsigned* bar, volatile LAS unsigned* st) {
    XcdBarrier b; b.bar = bar; b.x = xb_xcc_id(); b.st = st;
    if (threadIdx.x == 0) (void)xb_add(&bar[XB_XCNT(b.x)], 1u);
    return b;
}
__device__ __forceinline__ void xcd_barrier_complete(unsigned* bar, unsigned x, unsigned& nloc, unsigned& nx) {
    const unsigned G = gridDim.x * gridDim.y * gridDim.z;
    unsigned sum, cnt, mine, sp = 0u;
    for (;;) {
        sum = 0u; cnt = 0u; mine = 0u;
#pragma unroll
        for (unsigned j = 0; j < 16; ++j) { const unsigned c = xb_ld(&bar[XB_XCNT(j)]); sum += c; cnt += (c > 0u) ? 1u : 0u; mine = (j == x) ? c : mine; }
        if (sum == G) break;
        __builtin_amdgcn_s_sleep(1);
        if ((++sp & 255u) == 0u) { if (xb_ld(&bar[XB_TMO])) break; if (sp > XB_SPIN_CAP) { atomicAdd(&bar[XB_TMO], 1u); break; } }
    }
    nloc = mine > 0u ? mine : 1u; nx = cnt > 0u ? cnt : 1u;
}
__device__ __forceinline__ void xcd_barrier(const XcdBarrier& b) {
    asm volatile("s_waitcnt vmcnt(0)" ::: "memory");
    __syncthreads();
    if (threadIdx.x == 0) {
        unsigned* bar = b.bar;
        __builtin_amdgcn_s_waitcnt(0);
        unsigned nloc = b.st[0], nx = b.st[1];
        if (nloc == 0u) { xcd_barrier_complete(bar, b.x, nloc, nx); b.st[0] = nloc; b.st[1] = nx; }
        const unsigned old = xb_add(&bar[XB_XSUB(b.x)], 1u);
        const unsigned gen = old / nloc;
        if (old + 1u == (gen + 1u) * nloc) {
            __builtin_amdgcn_fence(__ATOMIC_RELEASE, "agent");
            asm volatile("s_waitcnt vmcnt(0)" ::: "memory");
            const unsigned og = xb_add(&bar[XB_TOP], 1u);
            const unsigned tg = og / nx;
            if (og + 1u == (tg + 1u) * nx) xb_add(&bar[XB_TOPGEN], 1u);
            else XB_SPIN(xb_ld(&bar[XB_TOPGEN]) == tg, bar);
            __builtin_amdgcn_fence(__ATOMIC_ACQUIRE, "agent");
            xb_add(&bar[XB_XGEN(b.x)], 1u);
            asm volatile("s_waitcnt vmcnt(0)" ::: "memory");
        } else {
            XB_SPIN(xb_ld(&bar[XB_XGEN(b.x)]) == gen, bar);
            __builtin_amdgcn_fence(__ATOMIC_ACQUIRE, "agent");
            asm volatile("s_waitcnt vmcnt(0)" ::: "memory");
        }
    }
    __syncthreads();
}

struct Args { const void* in[22]; float* out; unsigned char* ws; int ph_lo, ph_hi; };
#define A_x ((const float*)A.in[0])
#define A_c ((const float*)A.in[1])
#define A_pos ((const int*)A.in[2])
#define A_ada_w ((const float*)A.in[3])
#define A_ada_b ((const float*)A.in[4])
#define A_n1g ((const float*)A.in[5])
#define A_n2g ((const float*)A.in[6])
#define A_a_w_in ((const float*)A.in[7])
#define A_a_qg ((const float*)A.in[8])
#define A_a_kg ((const float*)A.in[9])
#define A_a_w_out ((const float*)A.in[10])
#define A_b_w_in ((const float*)A.in[11])
#define A_b_wg ((const float*)A.in[12])
#define A_b_gb ((const float*)A.in[13])
#define A_b_og ((const float*)A.in[14])
#define A_b_w_out ((const float*)A.in[15])
#define A_r_w ((const float*)A.in[16])
#define A_r_b ((const float*)A.in[17])
#define A_w_gu ((const float*)A.in[18])
#define A_b_gu ((const float*)A.in[19])
#define A_w_dn ((const float*)A.in[20])
#define A_b_dn ((const float*)A.in[21])
#define A_out (A.out)
#define A_mod ((float*)(A.ws + WS_MOD))
#define A_WTR ((bf16_t*)(A.ws + WS_WTR))
#define A_WTA ((bf16_t*)(A.ws + WS_WTA))
#define A_WAIN ((bf16_t*)(A.ws + WS_WAIN))
#define A_WAOUT ((bf16_t*)(A.ws + WS_WAOUT))
#define A_WBIN ((bf16_t*)(A.ws + WS_WBIN))
#define A_WBOUT ((bf16_t*)(A.ws + WS_WBOUT))
#define A_WGU ((bf16_t*)(A.ws + WS_WGU))
#define A_WDN ((bf16_t*)(A.ws + WS_WDN))
#define A_H ((bf16_t*)(A.ws + WS_H))
#define A_O ((bf16_t*)(A.ws + WS_O))
#define A_QKV ((bf16_t*)(A.ws + WS_R))
#define A_ACT ((bf16_t*)(A.ws + WS_ACT))
#define A_Y ((bf16_t*)(A.ws + WS_Y))
#define A_PROJ ((bf16_t*)(A.ws + WS_R))
#define A_LSE ((float*)(A.ws + WS_LSE))
#define A_APROJ ((float*)(A.ws + WS_APROJ))
#define A_GATEW ((float*)(A.ws + WS_GATEW))
#define A_XA ((float*)(A.ws + WS_XA))
#define A_TOKLIST ((unsigned*)(A.ws + WS_TOKLIST))
struct Frame {
    LAS unsigned char* lds;
    volatile LAS unsigned* MISC;
    gu32* ctl;
    int wave, G;
};
constexpr int NWAVES = 8;

__device__ __forceinline__ int perm5(int i) { return (((i >> 2) & 1) << 4) | ((i >> 3) << 2) | (i & 3); }
template <int MODE> __device__ __forceinline__ int dest_row(int n) {
    if (MODE == 0) return n;
    if (MODE == 1) return (n & ~255) | (((n >> 5) & 1) << 7) | (((n >> 6) & 3) << 5) | perm5(n & 31);
    const int bj = n >> 10, j = n & 1023; return ((j >> 7) << 8) | (bj << 7) | (((j >> 5) & 3) << 5) | perm5(j & 31);
}
template <int MODE> __device__ __forceinline__ void p0_transpose_item(const float* W, int ldw, int N, bf16_t* WT, LAS float* scr, int item, int lane) {
    const int nblk = N / 32, kb = item / nblk, nb = item % nblk, k0 = 64 * kb, n0 = 32 * nb;
#pragma unroll 8
    for (int i = 0; i < 32; ++i) { const int kk = 2 * i + (lane >> 5); scr[kk * 33 + (lane & 31)] = W[(size_t)(k0 + kk) * ldw + n0 + (lane & 31)]; }
    LDS_WAIT(); asm volatile("" ::: "memory");
    const int c = lane & 7;
#pragma unroll
    for (int j = 0; j < 4; ++j) { const int n = (lane >> 3) + 8 * j; const LAS float* s = scr + (8 * c) * 33 + n;
        u32x4 o; o.x = pk2(s[0 * 33], s[1 * 33]); o.y = pk2(s[2 * 33], s[3 * 33]); o.z = pk2(s[4 * 33], s[5 * 33]); o.w = pk2(s[6 * 33], s[7 * 33]);
        *(GAS u32x4*)(WT + (size_t)dest_row<MODE>(n0 + n) * 1024 + k0 + 8 * c) = o; }
    LDS_WAIT(); asm volatile("" ::: "memory");
}
__device__ __forceinline__ void p0_prologue(Frame& F, const Args& A) {
    LAS float* cond = (LAS float*)(F.lds + RING_OFF);
    for (int idx = ((int)threadIdx.x); idx < NB * D; idx += NWAVES * 64) { const int b = idx >> 10, k = idx & 1023; const float v = A_c[idx]; cond[k * 8 + b] = v / (1.0f + __expf(-v)); }
    __syncthreads();
    const int gw = blockIdx.x * NWAVES + F.wave, NGW = F.G * NWAVES;
    for (int it = gw; it < 2 * 192; it += NGW) {
        const int l = it / 192, nb = it % 192, col = 32 * nb + (((int)threadIdx.x & 63) & 31), kh = ((int)threadIdx.x & 63) >> 5;
        float acc[8];
#pragma unroll
        for (int b = 0; b < 8; ++b) acc[b] = 0.f;
        const float* wp = A_ada_w + ((size_t)l * D + kh * 512) * 6144 + col;
#pragma unroll 8
        for (int k = 0; k < 512; ++k) { const float w = wp[(size_t)k * 6144]; const f32x4 c0 = *(const LAS f32x4*)(cond + (kh * 512 + k) * 8), c1 = *(const LAS f32x4*)(cond + (kh * 512 + k) * 8 + 4);
            acc[0] += c0[0] * w; acc[1] += c0[1] * w; acc[2] += c0[2] * w; acc[3] += c0[3] * w; acc[4] += c1[0] * w; acc[5] += c1[1] * w; acc[6] += c1[2] * w; acc[7] += c1[3] * w; }
#pragma unroll
        for (int b = 0; b < 8; ++b) acc[b] += __shfl_xor(acc[b], 32);
        if (kh == 0) { const float bias = A_ada_b[l * 6144 + col];
#pragma unroll
            for (int b = 0; b < 8; ++b) A_mod[(size_t)(l * 8 + b) * 6144 + col] = acc[b] + bias; }
    }
    __syncthreads();
    LAS float* scr = (LAS float*)(F.lds + RING_OFF + F.wave * 16384);
    constexpr int I_AIN = 16 * (NQKV / 32), I_SQ = 16 * 32, I_BIN = 16 * (NPROJ / 32), I_GU = 16 * 64, I_DN = 16 * 32;
    constexpr int NITEMS = I_AIN + I_SQ + I_BIN + I_SQ + 64 * I_GU + 64 * I_DN;
    for (int it = gw; it < NITEMS; it += NGW) {
        int r = it;
        if (r < I_AIN) { p0_transpose_item<1>(A_a_w_in, NQKV, NQKV, A_WAIN, scr, r, ((int)threadIdx.x & 63)); continue; } r -= I_AIN;
        if (r < I_SQ) { p0_transpose_item<0>(A_a_w_out, D, D, A_WAOUT, scr, r, ((int)threadIdx.x & 63)); continue; } r -= I_SQ;
        if (r < I_BIN) { p0_transpose_item<1>(A_b_w_in, BIN_PITCH, NPROJ, A_WBIN, scr, r, ((int)threadIdx.x & 63)); continue; } r -= I_BIN;
        if (r < I_SQ) { p0_transpose_item<0>(A_b_w_out, D, D, A_WBOUT, scr, r, ((int)threadIdx.x & 63)); continue; } r -= I_SQ;
        if (r < 64 * I_GU) { const int mtx = r / I_GU; p0_transpose_item<2>(A_w_gu + (size_t)mtx * D * 2048, 2048, 2048, A_WGU + (size_t)mtx * 2048 * 1024, scr, r % I_GU, ((int)threadIdx.x & 63)); continue; } r -= 64 * I_GU;
        { const int mtx = r / I_DN; p0_transpose_item<1>(A_w_dn + (size_t)mtx * D * D, D, D, A_WDN + (size_t)mtx * 1024 * 1024, scr, r % I_DN, ((int)threadIdx.x & 63)); }
    }
    for (int idx = blockIdx.x * (NWAVES * 64) + ((int)threadIdx.x); idx < 2 * 32 * 1024 + 16 * 1024; idx += F.G * NWAVES * 64) {
        if (idx < 2 * 32 * 1024) { const int l = idx >> 15, e = (idx >> 10) & 31, k = idx & 1023; const float v = A_r_w[((size_t)l * D + k) * NE + e];
            const unsigned h = f2bf(v); A_WTR[((size_t)(l * 2) * 32 + e) * 1024 + k] = (bf16_t)h; A_WTR[((size_t)(l * 2 + 1) * 32 + e) * 1024 + k] = (bf16_t)f2bf(v - __builtin_bit_cast(float, h << 16)); }
        else { const int i2 = idx - 2 * 32 * 1024, e = i2 >> 10, k = i2 & 1023; const float v = A_b_w_in[(size_t)k * BIN_PITCH + NPROJ + e];
            const unsigned h = f2bf(v); A_WTA[(size_t)e * 1024 + k] = (bf16_t)h; A_WTA[(size_t)(16 + e) * 1024 + k] = (bf16_t)f2bf(v - __builtin_bit_cast(float, h << 16)); }
    }
}

__device__ __forceinline__ void load_row(const float* p, int lane, f32x4 (&v)[4]) {
    const GAS f32x4* r = (const GAS f32x4*)p + lane;
#pragma unroll
    for (int j = 0; j < 4; ++j) v[j] = r[64 * j];
}
__device__ __forceinline__ void store_row(float* p, int lane, const f32x4 (&v)[4]) {
    GAS f32x4* r = (GAS f32x4*)p + lane;
#pragma unroll
    for (int j = 0; j < 4; ++j) r[64 * j] = v[j];
}
__device__ __forceinline__ void store_row_bf16(bf16_t* p, int lane, const f32x4 (&v)[4]) {
    GAS u32x2* r = (GAS u32x2*)p + lane;
#pragma unroll
    for (int j = 0; j < 4; ++j) { u32x2 w; w.x = pk2(v[j][0], v[j][1]); w.y = pk2(v[j][2], v[j][3]); r[64 * j] = w; }
}
__device__ __forceinline__ void norm_mod(f32x4 (&v)[4], const float* g, const float* scale, const float* shift, int lane) {
    float ss = 0.f;
#pragma unroll
    for (int j = 0; j < 4; ++j) ss += (v[j][0] * v[j][0] + v[j][1] * v[j][1]) + (v[j][2] * v[j][2] + v[j][3] * v[j][3]);
    const float rinv = __builtin_amdgcn_rsqf(wave_sum(ss) * (1.0f / D) + RMS_EPS);
    f32x4 gv[4], sv[4], hv[4]; load_row(g, lane, gv); load_row(scale, lane, sv); load_row(shift, lane, hv);
#pragma unroll
    for (int j = 0; j < 4; ++j) v[j] = v[j] * rinv * gv[j] * (sv[j] + 1.0f) + hv[j];
}
__device__ __forceinline__ void p_norm1(Frame& F, const Args& A, const float* X, int layer) {
    const int gw = blockIdx.x * NWAVES + F.wave, NGW = F.G * NWAVES;
    for (int m = gw; m < NTOK; m += NGW) {
        f32x4 v[4]; load_row(X + (size_t)m * D, ((int)threadIdx.x & 63), v);
        const float* md = A_mod + (size_t)(layer * 8 + m / SEQ) * 6144;
        norm_mod(v, A_n1g + layer * D, md + 1024, md, ((int)threadIdx.x & 63));
        store_row_bf16(A_H + (size_t)m * D, ((int)threadIdx.x & 63), v);
    }
}
constexpr int TP = 2048 + 64;
constexpr int WTILE = 8 * TP;
__device__ __forceinline__ void tile_put(LAS char* tile, int r, int lane, const f32x4 (&v)[4]) {
#pragma unroll
    for (int j = 0; j < 4; ++j) { u32x2 hi, lo; hi.x = pk2(v[j][0], v[j][1]); hi.y = pk2(v[j][2], v[j][3]);
        lo.x = pk2(v[j][0] - bflo(hi.x), v[j][1] - bfhi(hi.x)); lo.y = pk2(v[j][2] - bflo(hi.y), v[j][3] - bfhi(hi.y));
        *(LAS u32x2*)(tile + r * TP + 512 * j + 8 * lane) = hi; *(LAS u32x2*)(tile + (4 + r) * TP + 512 * j + 8 * lane) = lo; }
}
template <int NEB> __device__ __forceinline__ void rows4_proj(const LAS char* tile, const bf16_t* Wt, int lane, f32x4 (&acc)[NEB]) {
    const LAS char* ap = tile + (lane & 3) * TP + (lane >> 4) * 16;
    const bf16_t* bp = Wt + (size_t)(lane & 15) * 1024 + (lane >> 4) * 8;
#pragma unroll
    for (int eb = 0; eb < NEB; ++eb) acc[eb] = (f32x4){0.f, 0.f, 0.f, 0.f};
#pragma unroll 4
    for (int ks = 0; ks < 32; ++ks) {
        const bf16x8 ah = *(const LAS bf16x8*)(ap + ks * 64), al = *(const LAS bf16x8*)(ap + 4 * TP + ks * 64);
#pragma unroll
        for (int eb = 0; eb < NEB; ++eb) { const bf16x8 bh = *(const bf16x8*)(bp + eb * 16 * 1024 + ks * 32), bl = *(const bf16x8*)(bp + (NEB + eb) * 16 * 1024 + ks * 32);
            acc[eb] = __builtin_amdgcn_mfma_f32_16x16x32_bf16(ah, bh, acc[eb], 0, 0, 0);
            acc[eb] = __builtin_amdgcn_mfma_f32_16x16x32_bf16(ah, bl, acc[eb], 0, 0, 0);
            acc[eb] = __builtin_amdgcn_mfma_f32_16x16x32_bf16(al, bh, acc[eb], 0, 0, 0); }
    }
}
__device__ __forceinline__ void p_norm2_route(Frame& F, const Args& A, const float* X, int layer) {
    LAS char* tile = (LAS char*)(F.lds + RING_OFF + F.wave * WTILE);
    LAS int* sel_e = (LAS int*)(F.lds + SEL_OFF); LAS float* sel_w = (LAS float*)(F.lds + SEL_OFF + 2048);
    LAS unsigned* lcnt = (LAS unsigned*)(F.lds + MISC_OFF) + 16; LAS unsigned* lbase = (LAS unsigned*)(F.lds + MISC_OFF) + 48;
    if (((int)threadIdx.x) < 32) lcnt[((int)threadIdx.x)] = 0u;
    __syncthreads();
    const bf16_t* Wt = A_WTR + (size_t)layer * 2 * 32 * 1024;
    const int le = ((int)threadIdx.x & 63) & 15;
    const float rb0 = A_r_b[layer * NE + le], rb1 = A_r_b[layer * NE + 16 + le];
    for (int ch = blockIdx.x; ch < NTOK / 128; ch += F.G) {
        const int tokbase = ch * 128;
#pragma unroll 1
        for (int g4 = 0; g4 < 4; ++g4) {
            const int tl = 16 * F.wave + 4 * g4;
#pragma unroll
            for (int r = 0; r < 4; ++r) { const int m = tokbase + tl + r; f32x4 h[4]; load_row(X + (size_t)m * D, ((int)threadIdx.x & 63), h);
                const float* md = A_mod + (size_t)(layer * 8 + m / SEQ) * 6144;
                norm_mod(h, A_n2g + layer * D, md + 4 * 1024, md + 3 * 1024, ((int)threadIdx.x & 63));
                store_row_bf16(A_H + (size_t)m * D, ((int)threadIdx.x & 63), h); tile_put(tile, r, ((int)threadIdx.x & 63), h); }
            LDS_WAIT(); asm volatile("" ::: "memory");
            f32x4 acc[2]; rows4_proj<2>(tile, Wt, ((int)threadIdx.x & 63), acc);
#pragma unroll
            for (int r = 0; r < 4; ++r) {
                const float va = acc[0][r] + rb0, vb = acc[1][r] + rb1;
                int ca = 0, cb = 0; float mx = __builtin_fmaxf(va, vb);
#pragma unroll 4
                for (int j = 0; j < 16; ++j) { const float la = __builtin_bit_cast(float, __builtin_amdgcn_readlane(__builtin_bit_cast(int, va), j)), lb = __builtin_bit_cast(float, __builtin_amdgcn_readlane(__builtin_bit_cast(int, vb), j));
                    ca += ((la > va || (la == va && j < le)) ? 1 : 0) + ((lb > va) ? 1 : 0);
                    cb += ((la >= vb) ? 1 : 0) + ((lb > vb || (lb == vb && j < le)) ? 1 : 0);
                    mx = __builtin_fmaxf(mx, __builtin_fmaxf(la, lb)); }
                const bool act = ((int)threadIdx.x & 63) < 16, sa = act && ca < 4, sb = act && cb < 4;
                const float pa = sa ? __expf(va - mx) : 0.f, pb = sb ? __expf(vb - mx) : 0.f; const float sum = wave_sum(pa + pb);
                if (sa) { sel_e[(tl + r) * 4 + ca] = le; sel_w[(tl + r) * 4 + ca] = pa / sum; }
                if (sb) { sel_e[(tl + r) * 4 + cb] = 16 + le; sel_w[(tl + r) * 4 + cb] = pb / sum; }
            }
            LDS_WAIT(); asm volatile("" ::: "memory");
        }
        __syncthreads();
        const int e = sel_e[((int)threadIdx.x)]; const float w = sel_w[((int)threadIdx.x)];
        const unsigned rank = __hip_atomic_fetch_add(lcnt + e, 1u, __ATOMIC_RELAXED, __HIP_MEMORY_SCOPE_WORKGROUP);
        __syncthreads();
        if (((int)threadIdx.x) < 32) { const unsigned n = lcnt[((int)threadIdx.x)]; lbase[((int)threadIdx.x)] = n ? __hip_atomic_fetch_add((unsigned*)(F.ctl + CW_CNT + (layer * 32 + ((int)threadIdx.x)) * 64), n, RLX_AGENT) : 0u; lcnt[((int)threadIdx.x)] = 0u; }
        __syncthreads();
        const unsigned slot = (unsigned)(tokbase * 4 + ((int)threadIdx.x));
        A_TOKLIST[(size_t)e * ECAP + lbase[e] + rank] = slot; A_GATEW[slot] = w;
#if MK_CHECK
        ((unsigned*)(A.ws + WS_DBG))[slot] = (unsigned)e;
#endif
        __syncthreads();
    }
}
template <bool NEXT> __device__ __forceinline__ void p_combine(Frame& F, const Args& A, const float* Xi, float* Xo, int layer) {
    LAS char* tile = (LAS char*)(F.lds + RING_OFF + F.wave * WTILE);
    const int gw = blockIdx.x * NWAVES + F.wave, NGW = F.G * NWAVES;
    for (int m4 = gw * 4; m4 < NTOK; m4 += NGW * 4) {
#pragma unroll
        for (int r = 0; r < 4; ++r) { const int m = m4 + r;
            f32x4 v[4]; load_row(Xi + (size_t)m * D, ((int)threadIdx.x & 63), v);
            const float* md = A_mod + (size_t)(layer * 8 + m / SEQ) * 6144;
            f32x4 g2[4]; load_row(md + 5 * 1024, ((int)threadIdx.x & 63), g2);
            f32x4 s[4];
#pragma unroll
            for (int j = 0; j < 4; ++j) s[j] = (f32x4){0.f, 0.f, 0.f, 0.f};
#pragma unroll
            for (int k = 0; k < 4; ++k) { const GAS u32x2* yr = (const GAS u32x2*)(A_Y + (size_t)(m * 4 + k) * D) + ((int)threadIdx.x & 63);
#pragma unroll
                for (int j = 0; j < 4; ++j) { const u32x2 w = yr[64 * j]; s[j][0] += bflo(w.x); s[j][1] += bfhi(w.x); s[j][2] += bflo(w.y); s[j][3] += bfhi(w.y); } }
#pragma unroll
            for (int j = 0; j < 4; ++j) v[j] = v[j] + g2[j] * s[j];
            store_row(Xo + (size_t)m * D, ((int)threadIdx.x & 63), v);
            if (NEXT) {
                const float* md1 = A_mod + (size_t)((layer + 1) * 8 + m / SEQ) * 6144;
                norm_mod(v, A_n1g + (layer + 1) * D, md1 + 1024, md1, ((int)threadIdx.x & 63));
                store_row_bf16(A_H + (size_t)m * D, ((int)threadIdx.x & 63), v); tile_put(tile, r, ((int)threadIdx.x & 63), v);
            }
            asm volatile("" ::: "memory");
        }
        if (NEXT) {
            LDS_WAIT(); asm volatile("" ::: "memory");
            f32x4 acc[1]; rows4_proj<1>(tile, A_WTA, ((int)threadIdx.x & 63), acc);
            if (((int)threadIdx.x & 63) < 16) {
#pragma unroll
                for (int r = 0; r < 4; ++r) A_APROJ[(size_t)(m4 + r) * 16 + ((int)threadIdx.x & 63)] = acc[0][r]; }
            LDS_WAIT(); asm volatile("" ::: "memory");
        }
    }
}

namespace att {
constexpr int NK = 384, KCH = NK * 16 + 16, VH = NK * 64 + 64;
constexpr int K_OFF = 0, V_OFF = 8 * KCH, ST_OFF = V_OFF + 2 * VH, WS_OFF = ST_OFF + 8 * 4096, BYTES = WS_OFF + 8 * 256;
static_assert(RING_OFF + BYTES <= LDS_BYTES, "attention LDS");
template <int GRP> __device__ __forceinline__ void unit(Frame& F, const Args& A, int b, int h, int r, int blk) {
    constexpr int dil = (GRP == 0) ? 1 : (GRP == 1) ? 4 : 16;
    const int tid = ((int)threadIdx.x), lane = ((int)threadIdx.x & 63), r32 = lane & 31, hi = lane >> 5, w = F.wave;
    const int u0 = blk * 256; const size_t rowb = (size_t)b * SEQ;
    int r32m = r32, tidm = tid, him = hi; asm volatile("" : "+v"(r32m), "+v"(tidm), "+v"(him));
    const bf16_t* Qg = A_QKV + GRP * 3072 + h * 64;
    LAS char* lds = (LAS char*)(F.lds + RING_OFF);
    u32x4 kv[6], vv[6];
#pragma unroll
    for (int i = 0; i < 6; ++i) { const int p = tid + 512 * i, key = p >> 3, c = p & 7, up = u0 - 128 + key;
        if (up >= 0) { const bf16_t* src = Qg + (rowb + (size_t)up * dil + r) * NQKV + c * 8; kv[i] = *(const u32x4*)(src + 1024); vv[i] = *(const u32x4*)(src + 2048); }
        else { kv[i] = (u32x4){0u, 0u, 0u, 0u}; vv[i] = kv[i]; } }
    bf16x8 qr[4];
    { const bf16_t* qp = Qg + (rowb + (size_t)(u0 + 32 * w + r32) * dil + r) * NQKV + hi * 8;
#pragma unroll
      for (int d0 = 0; d0 < 4; ++d0) qr[d0] = *(const bf16x8*)(qp + d0 * 16); }
#pragma unroll
    for (int i = 0; i < 6; ++i) { const int p = tidm + 512 * i, key = p >> 3, c = p & 7;
        *(LAS u32x4*)(lds + K_OFF + c * KCH + key * 16) = kv[i];
        *(LAS u32x4*)(lds + V_OFF + (c >> 2) * VH + key * 64 + (c & 3) * 16) = vv[i]; }
    __syncthreads();
    const int lo = (blk == 0) ? ((4 - w) > 0 ? (4 - w) : 0) : 0;
    f32x16 s[5];
    const float NEG = -INFINITY;
#pragma unroll
    for (int kp = 0; kp < 5; ++kp) {
        f32x16 a;
#pragma unroll
        for (int q = 0; q < 16; ++q) a[q] = (kp >= lo) ? 0.f : NEG;
        if (kp >= lo) {
            const LAS char* kb = lds + K_OFF + hi * KCH + ((w + kp) * 32 + r32) * 16;
#pragma unroll
            for (int d0 = 0; d0 < 4; ++d0) { const bf16x8 kf = *(const LAS bf16x8*)(kb + 2 * d0 * KCH); a = __builtin_amdgcn_mfma_f32_32x32x16_bf16(kf, qr[d0], a, 0, 0, 0); }
            if (kp == 0) {
#pragma unroll
                for (int q = 0; q < 16; ++q) if (crow(q, him) < r32m) a[q] = NEG; }
            if (kp == 4) {
#pragma unroll
                for (int q = 0; q < 16; ++q) if (crow(q, him) > r32m) a[q] = NEG; }
        }
        s[kp] = a;
    }
    float m = NEG;
#pragma unroll
    for (int kp = 0; kp < 5; ++kp)
#pragma unroll
        for (int q = 0; q < 16; ++q) m = __builtin_fmaxf(m, s[kp][q]);
    m = __builtin_fmaxf(m, __shfl_xor(m, 32));
    float l = 0.f;
#pragma unroll
    for (int kp = 0; kp < 5; ++kp)
#pragma unroll
        for (int q = 0; q < 16; ++q) { const float p = __builtin_amdgcn_exp2f(s[kp][q] - m); s[kp][q] = p; l += p; }
    l += __shfl_xor(l, 32);
    f32x16 o[2];
#pragma unroll
    for (int q = 0; q < 16; ++q) { o[0][q] = 0.f; o[1][q] = 0.f; }
    const LAS char* vb = lds + V_OFF + ((lane >> 4) & 1) * 32 + (lane & 3) * 8 + (4 * hi + ((lane & 15) >> 2)) * 64;
#pragma unroll
    for (int kp = 0; kp < 5; ++kp) {
        if (kp >= lo) {
            u32x4 pw0, pw1;
            pw0.x = cvt_pk_bf16(s[kp][0], s[kp][1]); pw0.y = cvt_pk_bf16(s[kp][2], s[kp][3]); pw0.z = cvt_pk_bf16(s[kp][4], s[kp][5]); pw0.w = cvt_pk_bf16(s[kp][6], s[kp][7]);
            pw1.x = cvt_pk_bf16(s[kp][8], s[kp][9]); pw1.y = cvt_pk_bf16(s[kp][10], s[kp][11]); pw1.z = cvt_pk_bf16(s[kp][12], s[kp][13]); pw1.w = cvt_pk_bf16(s[kp][14], s[kp][15]);
            const bf16x8 pa0 = __builtin_bit_cast(bf16x8, pw0), pa1 = __builtin_bit_cast(bf16x8, pw1);
#pragma unroll
            for (int d0 = 0; d0 < 2; ++d0) {
                const LAS char* vp = vb + d0 * VH + ((w + kp) * 32) * 64;
                const s16x4 l0 = tr_read(vp), h0 = tr_read(vp + 512), l1 = tr_read(vp + 1024), h1 = tr_read(vp + 1536);
                o[d0] = __builtin_amdgcn_mfma_f32_32x32x16_bf16(pa0, CAT8(l0, h0), o[d0], 0, 0, 0);
                o[d0] = __builtin_amdgcn_mfma_f32_32x32x16_bf16(pa1, CAT8(l1, h1), o[d0], 0, 0, 0);
            }
        }
    }
    LAS float* wsf = (LAS float*)(lds + WS_OFF + w * 256);
    LAS bf16_t* stg = (LAS bf16_t*)(lds + ST_OFF + w * 4096);
    if (hi == 0) { wsf[r32] = __builtin_amdgcn_rcpf(l); wsf[32 + r32] = m + __builtin_amdgcn_logf(l); }
    LDS_WAIT(); asm volatile("" ::: "memory");
    int hie = hi; asm volatile("" : "+v"(hie));
#pragma unroll
    for (int q = 0; q < 16; ++q) { const int orow = crow(q, hie); const float rl = wsf[orow];
        stg[orow * 64 + r32] = (bf16_t)f2bf(o[0][q] * rl); stg[orow * 64 + 32 + r32] = (bf16_t)f2bf(o[1][q] * rl); }
    LDS_WAIT(); asm volatile("" ::: "memory");
#pragma unroll
    for (int i = 0; i < 4; ++i) {
        const int row = i * 8 + (lane >> 3), ch = lane & 7;
        u32x4 v = *(const LAS u32x4*)(stg + row * 64 + ch * 8);
        const size_t grow = rowb + (size_t)(u0 + 32 * w + row) * dil + r;
        bf16_t* op = A_O + grow * D + h * 64 + ch * 8; float* lp = A_LSE + grow * 16 + h;
        float ln = wsf[32 + row];
        if (GRP > 0) {
            const u32x4 old = *(const u32x4*)op; const float lold = *lp;
            const float mx = __builtin_fmaxf(lold, ln), L = mx + __builtin_amdgcn_logf(__builtin_amdgcn_exp2f(lold - mx) + __builtin_amdgcn_exp2f(ln - mx));
            const float wo = __builtin_amdgcn_exp2f(lold - L), wn = __builtin_amdgcn_exp2f(ln - L);
            v.x = cvt_pk_bf16(bflo(old.x) * wo + bflo(v.x) * wn, bfhi(old.x) * wo + bfhi(v.x) * wn);
            v.y = cvt_pk_bf16(bflo(old.y) * wo + bflo(v.y) * wn, bfhi(old.y) * wo + bfhi(v.y) * wn);
            v.z = cvt_pk_bf16(bflo(old.z) * wo + bflo(v.z) * wn, bfhi(old.z) * wo + bfhi(v.z) * wn);
            v.w = cvt_pk_bf16(bflo(old.w) * wo + bflo(v.w) * wn, bfhi(old.w) * wo + bfhi(v.w) * wn);
            ln = L;
        }
        *(u32x4*)op = v; if (ch == 0) *lp = ln;
    }
    __syncthreads();
}
template <int GRP> __device__ __forceinline__ void phase(Frame& F, const Args& A) {
    constexpr int dil = (GRP == 0) ? 1 : (GRP == 1) ? 4 : 16;
    for (int id = blockIdx.x; id < NB * 16 * 16; id += F.G) { const int bh = id >> 4, wi = id & 15; unit<GRP>(F, A, bh >> 4, bh & 15, wi % dil, wi / dil); }
}
}

namespace gla {
constexpr int QCH = 64 * 16 + 16;
constexpr int TH = 64 * 64 + 64;
constexpr int QD_OFF = 0, KI_OFF = 16 * QCH, KD_OFF = 32 * QCH, V_OFF = KD_OFF + 4 * TH, OST_OFF = V_OFF + 8 * TH, OSTP = 528;
constexpr int A_OFF = OST_OFF + 64 * OSTP, SEG_OFF = A_OFF + 4096, DEC_OFF = SEG_OFF + 2048, WG_OFF = DEC_OFF + 512, BYTES = WG_OFF + 16 * 128 * 4;
static_assert(RING_OFF + BYTES <= LDS_BYTES, "gla LDS");
constexpr int NSEG = 8, CPS = SEQ / 64 / NSEG;
__device__ __forceinline__ int swap23(int d) { return (d & ~12) | ((d & 4) << 1) | ((d & 8) >> 1); }
#define GLA_PK(A, B) __builtin_bit_cast(bf16x8, (u32x4){cvt_pk_bf16(A[B], A[B + 1]), cvt_pk_bf16(A[B + 2], A[B + 3]), cvt_pk_bf16(A[B + 4], A[B + 5]), cvt_pk_bf16(A[B + 6], A[B + 7])})
template <bool FULL> __device__ __forceinline__ void chunk(Frame& F, const Args& A, int b, int hd, int n, f32x16 (&S)[4], float& dsum, float gbias) {
    const int lane = ((int)threadIdx.x & 63), r32 = lane & 31, hi = lane >> 5, w = F.wave;
    LAS char* lds = (LAS char*)(F.lds + RING_OFF);
    const LAS char* trb = lds + ((lane >> 4) & 1) * 32 + (lane & 3) * 8 + (4 * hi + ((lane & 15) >> 2)) * 64;
    const size_t row0 = (size_t)b * SEQ + n * 64;
    int tid = ((int)threadIdx.x); asm volatile("" : "+v"(tid));
    const int d = tid & 127, seg = tid >> 7, c_n = tid >> 3, sg_n = tid & 7;
    const int dsw = swap23(d);
    const int qwoff = (dsw >> 3) * QCH + (dsw & 7) * 2;
    const int kdoff = KD_OFF + (d >> 5) * TH + (d & 31) * 2;
    if (tid < 256) *(LAS f32x4*)(lds + A_OFF + tid * 16) = *(const f32x4*)(A_APROJ + row0 * 16 + tid * 4);
#pragma unroll
    for (int i = 0; i < 4; ++i) { const int p = tid + 512 * i, c = p >> 5, ch = p & 31;
        const u32x4 v = *(const u32x4*)(A_PROJ + (row0 + c) * NPROJ + 1024 + hd * 256 + ch * 8);
        *(LAS u32x4*)(lds + V_OFF + (ch >> 2) * TH + c * 64 + (ch & 3) * 16) = v; }
    unsigned qk[16];
#pragma unroll
    for (int i = 0; i < 16; ++i) { const bf16_t* pr = A_PROJ + (row0 + 16 * seg + i) * NPROJ + hd * 128 + d; qk[i] = (FULL ? (unsigned)pr[0] : 0u) | ((unsigned)pr[512] << 16); }
    __syncthreads();
    float cs[16]; float run = 0.f;
#pragma unroll
    for (int i = 0; i < 16; ++i) { const LAS f32x4* ap = (const LAS f32x4*)(lds + A_OFF + (16 * seg + i) * 64); float z = gbias;
#pragma unroll
        for (int j4 = 0; j4 < 4; ++j4) { const f32x4 a = ap[j4]; const LAS float* wgp = (const LAS float*)(lds + WG_OFF) + d;
            z += a[0] * wgp[(4 * j4) * 128] + a[1] * wgp[(4 * j4 + 1) * 128] + a[2] * wgp[(4 * j4 + 2) * 128] + a[3] * wgp[(4 * j4 + 3) * 128]; }
        const float sp = __builtin_fmaxf(-z, 0.f) + __logf(1.0f + __expf(-__builtin_fabsf(z)));
        run -= sp * (LOG2E / 16.0f); cs[i] = run; }
    ((LAS float*)(lds + SEG_OFF))[seg * 128 + d] = run;
    __syncthreads();
    float pre = 0.f, tot = 0.f;
#pragma unroll
    for (int s2 = 0; s2 < 4; ++s2) { const float t = ((const LAS float*)(lds + SEG_OFF))[s2 * 128 + d]; if (s2 < seg) pre += t; tot += t; }
    if (seg == 0) { ((LAS float*)(lds + DEC_OFF))[d] = __builtin_amdgcn_exp2f(tot); dsum += tot; }
#pragma unroll
    for (int i = 0; i < 16; ++i) { const int c = 16 * seg + i; const float bb = pre + cs[i];
        const float kf = bfhi(qk[i]);
        if (FULL) { const float qf = bflo(qk[i]);
            *(LAS bf16_t*)(lds + QD_OFF + qwoff + c * 16) = (bf16_t)f2bf(qf * 0.08838834764831845f * __builtin_amdgcn_exp2f(bb));
            *(LAS bf16_t*)(lds + KI_OFF + qwoff + c * 16) = (bf16_t)f2bf(kf * __builtin_amdgcn_exp2f(-bb)); }
        *(LAS bf16_t*)(lds + kdoff + c * 64) = (bf16_t)f2bf(kf * __builtin_amdgcn_exp2f(tot - bb)); }
    __syncthreads();
    const LAS char* vtr = trb + V_OFF + w * TH;
    bf16x8 v0, v1, v2, v3;
    { const s16x4 l0 = tr_read(vtr), h0 = tr_read(vtr + 512), l1 = tr_read(vtr + 1024), h1 = tr_read(vtr + 1536); v0 = CAT8(l0, h0); v1 = CAT8(l1, h1); }
    f32x16 o[2];
    if (FULL) {
#pragma unroll
        for (int q = 0; q < 16; ++q) { o[0][q] = 0.f; o[1][q] = 0.f; }
        const LAS char* kp = lds + KI_OFF + hi * QCH + r32 * 16; const LAS char* qp = lds + QD_OFF + hi * QCH + r32 * 16;
        { f32x16 a00;
#pragma unroll
          for (int q = 0; q < 16; ++q) a00[q] = 0.f;
#pragma unroll
          for (int ks = 0; ks < 8; ++ks) a00 = __builtin_amdgcn_mfma_f32_32x32x16_bf16(*(const LAS bf16x8*)(kp + 2 * ks * QCH), *(const LAS bf16x8*)(qp + 2 * ks * QCH), a00, 0, 0, 0);
#pragma unroll
          for (int q = 0; q < 16; ++q) if (crow(q, hi) > r32) a00[q] = 0.f;
          o[0] = __builtin_amdgcn_mfma_f32_32x32x16_bf16(GLA_PK(a00, 0), v0, o[0], 0, 0, 0);
          o[0] = __builtin_amdgcn_mfma_f32_32x32x16_bf16(GLA_PK(a00, 8), v1, o[0], 0, 0, 0); }
        __builtin_amdgcn_sched_barrier(0);
        { f32x16 a01;
#pragma unroll
          for (int q = 0; q < 16; ++q) a01[q] = 0.f;
#pragma unroll
          for (int ks = 0; ks < 8; ++ks) a01 = __builtin_amdgcn_mfma_f32_32x32x16_bf16(*(const LAS bf16x8*)(kp + 2 * ks * QCH), *(const LAS bf16x8*)(qp + 2 * ks * QCH + 512), a01, 0, 0, 0);
          o[1] = __builtin_amdgcn_mfma_f32_32x32x16_bf16(GLA_PK(a01, 0), v0, o[1], 0, 0, 0);
          o[1] = __builtin_amdgcn_mfma_f32_32x32x16_bf16(GLA_PK(a01, 8), v1, o[1], 0, 0, 0); }
        __builtin_amdgcn_sched_barrier(0);
    }
    { const s16x4 l2 = tr_read(vtr + 2048), h2 = tr_read(vtr + 2560), l3 = tr_read(vtr + 3072), h3 = tr_read(vtr + 3584); v2 = CAT8(l2, h2); v3 = CAT8(l3, h3); }
    if (FULL) {
        const LAS char* kp = lds + KI_OFF + hi * QCH + r32 * 16; const LAS char* qp = lds + QD_OFF + hi * QCH + r32 * 16;
        { f32x16 a11;
#pragma unroll
          for (int q = 0; q < 16; ++q) a11[q] = 0.f;
#pragma unroll
          for (int ks = 0; ks < 8; ++ks) a11 = __builtin_amdgcn_mfma_f32_32x32x16_bf16(*(const LAS bf16x8*)(kp + 2 * ks * QCH + 512), *(const LAS bf16x8*)(qp + 2 * ks * QCH + 512), a11, 0, 0, 0);
#pragma unroll
          for (int q = 0; q < 16; ++q) if (crow(q, hi) > r32) a11[q] = 0.f;
          o[1] = __builtin_amdgcn_mfma_f32_32x32x16_bf16(GLA_PK(a11, 0), v2, o[1], 0, 0, 0);
          o[1] = __builtin_amdgcn_mfma_f32_32x32x16_bf16(GLA_PK(a11, 8), v3, o[1], 0, 0, 0); }
        __builtin_amdgcn_sched_barrier(0);
#pragma unroll
        for (int k = 0; k < 4; ++k)
#pragma unroll
            for (int s2 = 0; s2 < 2; ++s2) { const bf16x8 sb = GLA_PK(S[k], 8 * s2);
                const bf16x8 q0 = *(const LAS bf16x8*)(qp + (4 * k + 2 * s2) * QCH), q1 = *(const LAS bf16x8*)(qp + (4 * k + 2 * s2) * QCH + 512);
                o[0] = __builtin_amdgcn_mfma_f32_32x32x16_bf16(q0, sb, o[0], 0, 0, 0);
                o[1] = __builtin_amdgcn_mfma_f32_32x32x16_bf16(q1, sb, o[1], 0, 0, 0); }
    }
#pragma unroll
    for (int k = 0; k < 4; ++k) {
#pragma unroll
        for (int q4 = 0; q4 < 4; ++q4) { const f32x4 dc = *(const LAS f32x4*)(lds + DEC_OFF + (32 * k + 8 * q4 + 4 * hi) * 4);
            S[k][4 * q4] *= dc[0]; S[k][4 * q4 + 1] *= dc[1]; S[k][4 * q4 + 2] *= dc[2]; S[k][4 * q4 + 3] *= dc[3]; }
        const LAS char* ktr = trb + KD_OFF + k * TH;
        const s16x4 kl0 = tr_read(ktr), kh0 = tr_read(ktr + 512), kl1 = tr_read(ktr + 1024), kh1 = tr_read(ktr + 1536);
        const s16x4 kl2 = tr_read(ktr + 2048), kh2 = tr_read(ktr + 2560), kl3 = tr_read(ktr + 3072), kh3 = tr_read(ktr + 3584);
        S[k] = __builtin_amdgcn_mfma_f32_32x32x16_bf16(CAT8(kl0, kh0), v0, S[k], 0, 0, 0);
        S[k] = __builtin_amdgcn_mfma_f32_32x32x16_bf16(CAT8(kl1, kh1), v1, S[k], 0, 0, 0);
        S[k] = __builtin_amdgcn_mfma_f32_32x32x16_bf16(CAT8(kl2, kh2), v2, S[k], 0, 0, 0);
        S[k] = __builtin_amdgcn_mfma_f32_32x32x16_bf16(CAT8(kl3, kh3), v3, S[k], 0, 0, 0);
    }
    if (FULL) {
#pragma unroll
        for (int cb = 0; cb < 2; ++cb)
#pragma unroll
            for (int q = 0; q < 16; ++q) *(LAS bf16_t*)(lds + OST_OFF + (32 * cb + crow(q, hi)) * OSTP + (32 * w + r32) * 2) = (bf16_t)f2bf(o[cb][q]);
        __syncthreads();
        u32x4 ov[4]; float ss = 0.f;
#pragma unroll
        for (int i = 0; i < 4; ++i) { ov[i] = *(const LAS u32x4*)(lds + OST_OFF + c_n * OSTP + sg_n * 64 + i * 16);
            const float a0 = bflo(ov[i].x), a1 = bfhi(ov[i].x), a2 = bflo(ov[i].y), a3 = bfhi(ov[i].y), a4 = bflo(ov[i].z), a5 = bfhi(ov[i].z), a6 = bflo(ov[i].w), a7 = bfhi(ov[i].w);
            ss += (a0 * a0 + a1 * a1) + (a2 * a2 + a3 * a3) + (a4 * a4 + a5 * a5) + (a6 * a6 + a7 * a7); }
        ss += __shfl_xor(ss, 1); ss += __shfl_xor(ss, 2); ss += __shfl_xor(ss, 4);
        const float rinv = __builtin_amdgcn_rsqf(ss * (1.0f / 256.0f) + RMS_EPS);
        const bf16_t* rp = A_PROJ + (row0 + c_n) * NPROJ + 2048 + hd * 256 + 32 * sg_n;
        bf16_t* op = A_O + (row0 + c_n) * D + hd * 256 + 32 * sg_n;
#pragma unroll
        for (int i = 0; i < 4; ++i) { const u32x4 rv = *(const u32x4*)(rp + 8 * i); u32x4 res; float og[8];
            { const f32x4 g0 = *(const f32x4*)(A_b_og + 32 * sg_n + 8 * i), g1 = *(const f32x4*)(A_b_og + 32 * sg_n + 8 * i + 4); og[0] = g0[0]; og[1] = g0[1]; og[2] = g0[2]; og[3] = g0[3]; og[4] = g1[0]; og[5] = g1[1]; og[6] = g1[2]; og[7] = g1[3]; }
            const unsigned ow[4] = {ov[i].x, ov[i].y, ov[i].z, ov[i].w}, rw[4] = {rv.x, rv.y, rv.z, rv.w}; unsigned out[4];
#pragma unroll
            for (int j = 0; j < 4; ++j) { const float r0 = bflo(rw[j]), r1 = bfhi(rw[j]);
                const float s0 = r0 * __builtin_amdgcn_rcpf(1.0f + __builtin_amdgcn_exp2f(-LOG2E * r0)), s1 = r1 * __builtin_amdgcn_rcpf(1.0f + __builtin_amdgcn_exp2f(-LOG2E * r1));
                out[j] = cvt_pk_bf16(bflo(ow[j]) * rinv * og[2 * j] * s0, bfhi(ow[j]) * rinv * og[2 * j + 1] * s1); }
            res.x = out[0]; res.y = out[1]; res.z = out[2]; res.w = out[3];
            *(u32x4*)(op + 8 * i) = res; }
    }
    __syncthreads();
}
template <class Bar> __device__ __forceinline__ void phase(Frame& F, const Args& A, const Bar& bar) {
    const int lane = ((int)threadIdx.x & 63), r32 = lane & 31, hi = lane >> 5, w = F.wave;
    LAS char* lds = (LAS char*)(F.lds + RING_OFF);
    const int d0 = ((int)threadIdx.x) & 127, sg0 = ((int)threadIdx.x) >> 7;
    float* const GS = (float*)(A.ws + WS_GS); float* const GD = (float*)(A.ws + WS_GD);
    for (int item = blockIdx.x; item < NB * 4 * NSEG; item += F.G) {
        const int sgm = item % NSEG, bh = item / NSEG, b = bh >> 2, hd = bh & 3;
        if (sgm == NSEG - 1) continue;
        if (sg0 == 0) {
#pragma unroll
            for (int j = 0; j < 16; ++j) ((LAS float*)(lds + WG_OFF))[j * 128 + d0] = A_b_wg[j * 512 + hd * 128 + d0]; }
        const float gbias = A_b_gb[hd * 128 + d0];
        f32x16 S[4];
#pragma unroll
        for (int k = 0; k < 4; ++k)
#pragma unroll
            for (int q = 0; q < 16; ++q) S[k][q] = 0.f;
        float dsum = 0.f;
#pragma unroll 1
        for (int n = 0; n < CPS; ++n) chunk<false>(F, A, b, hd, sgm * CPS + n, S, dsum, gbias);
        float* gs = GS + (size_t)item * 128 * 256;
#pragma unroll
        for (int k = 0; k < 4; ++k)
#pragma unroll
            for (int q = 0; q < 16; ++q) gs[(32 * k + crow(q, hi)) * 256 + 32 * w + r32] = S[k][q];
        if (sg0 == 0) GD[item * 128 + d0] = dsum;
    }
    xcd_barrier(bar);
    for (int item = blockIdx.x; item < NB * 4 * NSEG; item += F.G) {
        const int sgm = item % NSEG, bh = item / NSEG, b = bh >> 2, hd = bh & 3;
        constexpr int SIP = 1040;
        static_assert(RING_OFF + 128 * SIP <= LDS_BYTES, "gla start-state image");
#pragma unroll 1
        for (int j = 0; j < 16; ++j) { const int e4 = ((int)threadIdx.x) + 512 * j, dk = e4 >> 6, c4 = e4 & 63;
            f32x4 acc = (f32x4){0.f, 0.f, 0.f, 0.f}; float al = 0.f;
            for (int sp = sgm - 1; sp >= 0; --sp) { const f32x4 g = *(const f32x4*)(GS + (size_t)(bh * NSEG + sp) * 128 * 256 + dk * 256 + c4 * 4);
                acc = acc + g * __builtin_amdgcn_exp2f(al); al += GD[(bh * NSEG + sp) * 128 + dk]; }
            *(LAS f32x4*)(lds + dk * SIP + c4 * 16) = acc; }
        __syncthreads();
        f32x16 S[4];
#pragma unroll
        for (int k = 0; k < 4; ++k)
#pragma unroll
            for (int q = 0; q < 16; ++q) S[k][q] = *(const LAS float*)(lds + (32 * k + crow(q, hi)) * SIP + (32 * w + r32) * 4);
        __syncthreads();
        if (sg0 == 0) {
#pragma unroll
            for (int j = 0; j < 16; ++j) ((LAS float*)(lds + WG_OFF))[j * 128 + d0] = A_b_wg[j * 512 + hd * 128 + d0]; }
        const float gbias = A_b_gb[hd * 128 + d0];
        float dsum = 0.f;
#pragma unroll 1
        for (int n = 0; n < CPS; ++n) chunk<true>(F, A, b, hd, sgm * CPS + n, S, dsum, gbias);
    }
}
#undef GLA_PK
}

__device__ __forceinline__ int moe_build_units(Frame& F, const Args& A, int layer, int npn) {
    LAS int* tstart = (LAS int*)(F.lds + MISC_OFF) + 80; LAS int* ecnt = (LAS int*)(F.lds + MISC_OFF) + 128; LAS int* ulist = (LAS int*)(F.lds + SEL_OFF);
    if (((int)threadIdx.x) < 32) ecnt[((int)threadIdx.x)] = (int)__hip_atomic_load((unsigned*)(F.ctl + CW_CNT + (layer * 32 + ((int)threadIdx.x)) * 64), RLX_AGENT);
    __syncthreads();
    if (((int)threadIdx.x) == 0) { int s = 0; for (int e = 0; e < 32; ++e) { tstart[e] = s; s += (ecnt[e] + 255) >> 8; } tstart[32] = s; }
    __syncthreads();
    const int utot = tstart[32] * npn;
    int lo, hi, step, first;
    if (F.G % 8 == 0) { const int x = blockIdx.x % 8; lo = (int)(((long)utot * x) / 8); hi = (int)(((long)utot * (x + 1)) / 8); step = F.G / 8; first = blockIdx.x / 8; }
    else { lo = 0; hi = utot; step = F.G; first = blockIdx.x; }
    const int span = hi - lo - first; const int n = span > 0 ? (span + step - 1) / step : 0;
    if (((int)threadIdx.x) < n && ((int)threadIdx.x) < 1024) {
        const int L = lo + first + step * ((int)threadIdx.x), T = L / npn, pn = L % npn;
        int e = 0;
#pragma unroll
        for (int bit = 16; bit >= 1; bit >>= 1) if (e + bit < 32 && tstart[e + bit] <= T) e += bit;
        ulist[((int)threadIdx.x)] = e | ((T - tstart[e]) << 8) | (pn << 20);
    }
    __syncthreads();
    return n < 512 ? n : 512;
}


#if MK_CHECK
__device__ __forceinline__ float bf16r(float v) { return __builtin_bit_cast(float, f2bf(v) << 16); }
__device__ __forceinline__ void dbg_check_moe(Frame& F, const Args& A, int layer) {
    LAS float* hrow = (LAS float*)(F.lds + RING_OFF); LAS float* act = hrow + 1024;
    float werr = 0.f, wref = 0.f;
    for (int s = blockIdx.x; s < 1024; s += F.G) {
        const unsigned slot = (unsigned)((s * 127 + 5) % NASSIGN); const int tok = slot >> 2; const int e = (int)((const unsigned*)(A.ws + WS_DBG))[slot]; const float w = A_GATEW[slot];
        for (int k = ((int)threadIdx.x); k < 1024; k += 512) hrow[k] = __builtin_bit_cast(float, (unsigned)A_H[(size_t)tok * D + k] << 16);
        __syncthreads();
        const float* wgu = A_w_gu + ((size_t)layer * 32 + e) * D * 2048; const float* bgu = A_b_gu + ((size_t)layer * 32 + e) * 2048;
        for (int jj = 0; jj < 2; ++jj) { const int j = ((int)threadIdx.x) + 512 * jj; float g = 0.f, u = 0.f;
#pragma unroll 8
            for (int k = 0; k < 1024; ++k) { g += hrow[k] * bf16r(wgu[(size_t)k * 2048 + j]); u += hrow[k] * bf16r(wgu[(size_t)k * 2048 + 1024 + j]); }
            g += bgu[j]; u += bgu[1024 + j];
            const float gt = __builtin_fminf(g, 7.0f), up = __builtin_fminf(__builtin_fmaxf(u, -7.0f), 7.0f);
            act[j] = bf16r((up + 1.0f) * gt / (1.0f + __expf(-1.702f * gt))); }
        __syncthreads();
        const float* wdn = A_w_dn + ((size_t)layer * 32 + e) * D * D; const float* bdn = A_b_dn + ((size_t)layer * 32 + e) * D;
        for (int nn = 0; nn < 2; ++nn) { const int n = ((int)threadIdx.x) + 512 * nn; float y = 0.f;
#pragma unroll 8
            for (int j = 0; j < 1024; ++j) y += act[j] * bf16r(wdn[(size_t)j * D + n]);
            y = w * (y + bdn[n]);
            const float got = __builtin_bit_cast(float, (unsigned)A_Y[(size_t)slot * D + n] << 16);
            const float df = got - y; werr += (df == df) ? df * df : 1e6f; wref += y * y; }
        __syncthreads();
    }
    werr = wave_sum(werr); wref = wave_sum(wref);
    if (((int)threadIdx.x & 63) == 0) { atomicAdd((float*)(F.ctl + CW_DBG), werr); atomicAdd((float*)(F.ctl + CW_DBG + 1), wref); }
}
__device__ __forceinline__ void dbg_check_attn(Frame& F, const Args& A) {
    LAS float* sc = (LAS float*)(F.lds + RING_OFF);
    LAS float* red = sc + 512;
    float werr = 0.f, wref = 0.f;
    for (int s = blockIdx.x; s < 1024; s += F.G) {
        const int b = s & 7, t = ((s >> 3) * 33 + (s & 7) * 517) % SEQ, h = (s * 5) & 15; const size_t row = (size_t)b * SEQ + t;
        float sv = -INFINITY;
        if (((int)threadIdx.x) < 387) { const int g = ((int)threadIdx.x) / 129, j = ((int)threadIdx.x) % 129, dil = (g == 0) ? 1 : (g == 1) ? 4 : 16; const int tj = t - j * dil;
            if (tj >= 0) { const bf16_t* qp = A_QKV + row * NQKV + g * 3072 + h * 64; const bf16_t* kp = A_QKV + ((size_t)b * SEQ + tj) * NQKV + g * 3072 + 1024 + h * 64; float a = 0.f;
                for (int d = 0; d < 64; ++d) a += __builtin_bit_cast(float, (unsigned)qp[d] << 16) * __builtin_bit_cast(float, (unsigned)kp[d] << 16);
                sv = a; } }
        sc[((int)threadIdx.x)] = sv;
        __syncthreads();
        float m = -INFINITY; for (int i = 0; i < 387; ++i) m = __builtin_fmaxf(m, sc[i]);
        float l = 0.f; for (int i = 0; i < 387; ++i) l += __builtin_amdgcn_exp2f(sc[i] - m);
        if (((int)threadIdx.x) < 64) { float o = 0.f;
            for (int i = 0; i < 387; ++i) { const float p = __builtin_amdgcn_exp2f(sc[i] - m); if (p > 0.f) { const int g = i / 129, j = i % 129, dil = (g == 0) ? 1 : (g == 1) ? 4 : 16;
                o += p * __builtin_bit_cast(float, (unsigned)A_QKV[((size_t)b * SEQ + t - j * dil) * NQKV + g * 3072 + 2048 + h * 64 + ((int)threadIdx.x)] << 16); } }
            o /= l;
            const float got = __builtin_bit_cast(float, (unsigned)A_O[row * D + h * 64 + ((int)threadIdx.x)] << 16);
            const float df = got - o; werr += (df == df) ? df * df : 1e6f; wref += o * o; }
        __syncthreads();
    }
    werr = wave_sum(werr); wref = wave_sum(wref);
    if (((int)threadIdx.x & 63) == 0) { atomicAdd((float*)(F.ctl + CW_DBG), werr); atomicAdd((float*)(F.ctl + CW_DBG + 1), wref); }
}
__device__ __forceinline__ void dbg_check_gla(Frame& F, const Args& A) {
    float werr = 0.f, wref = 0.f;
    if (blockIdx.x < 8) {
        const int b = blockIdx.x, hd = blockIdx.x & 3;
        LAS float* al = (LAS float*)(F.lds + RING_OFF); LAS float* qq = al + 128; LAS float* kk = qq + 128; LAS float* ov = kk + 128;
        float S[128];
#pragma unroll
        for (int d = 0; d < 128; ++d) S[d] = 0.f;
        for (int t = 0; t < 256; ++t) {
            const size_t row = (size_t)b * SEQ + t;
            if (((int)threadIdx.x) < 128) { const int d = ((int)threadIdx.x); float z = A_b_gb[hd * 128 + d];
                for (int j = 0; j < 16; ++j) z += A_APROJ[row * 16 + j] * A_b_wg[j * 512 + hd * 128 + d];
                const float sp = __builtin_fmaxf(-z, 0.f) + __logf(1.0f + __expf(-__builtin_fabsf(z)));
                al[d] = __expf(-sp / 16.0f);
                qq[d] = __builtin_bit_cast(float, (unsigned)A_PROJ[row * NPROJ + hd * 128 + d] << 16) * 0.08838834764831845f;
                kk[d] = __builtin_bit_cast(float, (unsigned)A_PROJ[row * NPROJ + 512 + hd * 128 + d] << 16); }
            __syncthreads();
            if (((int)threadIdx.x) < 256) { const float v = __builtin_bit_cast(float, (unsigned)A_PROJ[row * NPROJ + 1024 + hd * 256 + ((int)threadIdx.x)] << 16); float o = 0.f;
#pragma unroll
                for (int d = 0; d < 128; ++d) { S[d] = al[d] * S[d] + kk[d] * v; o += qq[d] * S[d]; }
                ov[((int)threadIdx.x)] = o; }
            __syncthreads();
            if (((int)threadIdx.x) < 256) { float ss = 0.f; for (int i = 0; i < 256; ++i) ss += ov[i] * ov[i];
                const float rinv = 1.0f / sqrtf(ss / 256.0f + RMS_EPS);
                const float r = __builtin_bit_cast(float, (unsigned)A_PROJ[row * NPROJ + 2048 + hd * 256 + ((int)threadIdx.x)] << 16);
                const float ref = ov[((int)threadIdx.x)] * rinv * A_b_og[((int)threadIdx.x)] * (r / (1.0f + __expf(-r)));
                const float got = __builtin_bit_cast(float, (unsigned)A_O[row * D + hd * 256 + ((int)threadIdx.x)] << 16);
                const float df = got - ref; werr += (df == df) ? df * df : 1e6f; wref += ref * ref; }
            __syncthreads();
        }
    }
    werr = wave_sum(werr); wref = wave_sum(wref);
    if (((int)threadIdx.x & 63) == 0) { atomicAdd((float*)(F.ctl + CW_DBG), werr); atomicAdd((float*)(F.ctl + CW_DBG + 1), wref); }
}
#endif
enum Phase { P_PRO = 0, P_N1, P_QKV, P_ATT0, P_ATT1, P_ATT2, P_AOUT, P_R0, P_GU0, P_DN0, P_C0, P_BIN, P_GLA, P_BOUT, P_R1, P_GU1, P_DN1, P_C1, P_COUNT };

__global__ void __launch_bounds__(NWAVES * 64, 2) mk_fwd(Args args) {
    extern __shared__ __attribute__((aligned(16))) unsigned char lds_raw[];
    Frame F;
    F.lds = (LAS unsigned char*)lds_raw;
    F.MISC = (volatile LAS unsigned*)(F.lds + MISC_OFF);
    F.wave = __builtin_amdgcn_readfirstlane(((int)threadIdx.x) >> 6); F.G = gridDim.x;
    const Args& A = args;
    F.ctl = (gu32*)(A.ws + WS_CTL);
    for (int u = ((int)threadIdx.x); u < RING_OFF / 4; u += NWAVES * 64) ((LAS unsigned*)F.lds)[u] = 0u;
    __syncthreads();
    XcdBarrier bar; bar.bar = (unsigned*)(F.ctl + CW_BAR); bar.x = 0; bar.st = nullptr;
    if (!MK_PER_PHASE) bar = xcd_barrier_post((unsigned*)(F.ctl + CW_BAR), F.MISC + 8);
    const int lo = args.ph_lo, hi = args.ph_hi;
#ifndef ONLY_PHASE
#define ONLY_PHASE -1
#endif
#define IN(k) ((ONLY_PHASE < 0 || ONLY_PHASE == (k)) && lo <= (k) && (k) < hi && (k) <= MK_LAST_PHASE)
#define SEAM(k) do { if (!MK_PER_PHASE && (k) + 1 < hi) xcd_barrier(bar); } while (0)
    LAS unsigned char* ring = F.lds + RING_OFF; LAS unsigned* tab = (LAS unsigned*)(F.lds + TAB_OFF);
    float* const XB = A_out;

#define DUP(k) (((MK_DUP >> (k)) & 1u) != 0u)
#define PHASE(k, ...) do { if (IN(k)) { __VA_ARGS__ } if (DUP(k) && IN(k)) { __VA_ARGS__ } } while (0)
#define B_QKV pg8::DenseSched S; S.init(A_H, A_WAIN, NTOK, NQKV, F.G, (int)blockIdx.x); pg8::EpiQKV E{A_QKV, A_pos, A_a_qg, A_a_kg}; pg8::gemm_phase(ring, tab, S, E); SEAM(P_QKV);
#define B_ATT if (MK_PROBE == 0 || MK_PROBE == 5 || MK_PROBE == 6) { att::phase<0>(F, A); SEAM(P_ATT0); } if (MK_PROBE == 0 || MK_PROBE == 6) { att::phase<1>(F, A); SEAM(P_ATT1); } if (MK_PROBE == 0) { att::phase<2>(F, A); SEAM(P_ATT2); }
#define B_AOUT pg8::DenseSched S; \
        if (MK_PROBE == 1) S.init(A_H, A_WAOUT, NTOK, D, F.G, (int)blockIdx.x); \
        else if (MK_PROBE == 2) S.init(A_QKV + 2048, A_WAOUT, NTOK, D, F.G, (int)blockIdx.x, NQKV); \
        else if (MK_PROBE == 3) S.init(A_QKV, A_WAOUT, NTOK, D, F.G, (int)blockIdx.x, NQKV); \
        else if (MK_PROBE == 4) S.init(A_QKV + 1024, A_WAOUT, NTOK, D, F.G, (int)blockIdx.x, NQKV); \
        else S.init(A_O, A_WAOUT, NTOK, D, F.G, (int)blockIdx.x); \
        pg8::EpiResid E{A_x, A_XA, A_mod + 2 * 1024}; pg8::gemm_phase(ring, tab, S, E); SEAM(P_AOUT);
#define B_GU(L, PGU) const int n = moe_build_units(F, A, L, 8); \
        pg8::MoeSched<true> S{(const LAS int*)(F.lds + SEL_OFF), n, (const LAS int*)(F.lds + MISC_OFF) + 80, (const LAS int*)(F.lds + MISC_OFF) + 128, A_H, A_WGU + (size_t)(L) * 32 * 2048 * 1024, (size_t)2048 * 1024 * 2, A_TOKLIST}; \
        pg8::EpiGLU E{A_ACT, A_b_gu + (size_t)(L) * 32 * 2048, (const LAS int*)(F.lds + MISC_OFF) + 80}; \
        pg8::gemm_phase(ring, tab, S, E); SEAM(PGU);
#define B_DN(L, PDN) const int n = moe_build_units(F, A, L, 4); \
        pg8::MoeSched<false> S{(const LAS int*)(F.lds + SEL_OFF), n, (const LAS int*)(F.lds + MISC_OFF) + 80, (const LAS int*)(F.lds + MISC_OFF) + 128, A_ACT, A_WDN + (size_t)(L) * 32 * 1024 * 1024, (size_t)1024 * 1024 * 2, A_TOKLIST}; \
        pg8::EpiDown E{A_Y, A_b_dn + (size_t)(L) * 32 * 1024, A_GATEW}; \
        pg8::gemm_phase(ring, tab, S, E); SEAM(PDN);
#define B_BIN pg8::DenseSched S; S.init(A_H, A_WBIN, NTOK, NPROJ, F.G, (int)blockIdx.x); pg8::EpiBf16Plain E{A_PROJ, NPROJ}; pg8::gemm_phase(ring, tab, S, E); SEAM(P_BIN);
#define B_BOUT pg8::DenseSched S; S.init(A_O, A_WBOUT, NTOK, D, F.G, (int)blockIdx.x); pg8::EpiResid E{XB, A_XA, A_mod + 8 * 6144 + 2 * 1024}; pg8::gemm_phase(ring, tab, S, E); SEAM(P_BOUT);
#if MK_CHECK == 1 || MK_CHECK == 2
#define DBG_MOE(L) if (MK_CHECK == (L) + 1) { dbg_check_moe(F, A, L); xcd_barrier(bar); }
#else
#define DBG_MOE(L)
#endif
    PHASE(P_PRO, p0_prologue(F, A); SEAM(P_PRO););
    PHASE(P_N1, p_norm1(F, A, A_x, 0); SEAM(P_N1););
    PHASE(P_QKV, B_QKV);
    PHASE(P_ATT0, B_ATT);
#if MK_CHECK == 3
    dbg_check_attn(F, A); xcd_barrier(bar);
#endif
    PHASE(P_AOUT, B_AOUT);
    if (IN(P_R0)) { p_norm2_route(F, A, A_XA, 0); SEAM(P_R0); }
    PHASE(P_GU0, B_GU(0, P_GU0));
    PHASE(P_DN0, B_DN(0, P_DN0));
    DBG_MOE(0)
    PHASE(P_C0, p_combine<true>(F, A, A_XA, XB, 0); SEAM(P_C0););
    PHASE(P_BIN, B_BIN);
    PHASE(P_GLA, gla::phase(F, A, bar); SEAM(P_GLA););
#if MK_CHECK == 4
    dbg_check_gla(F, A); xcd_barrier(bar);
#endif
    PHASE(P_BOUT, B_BOUT);
    if (IN(P_R1)) { p_norm2_route(F, A, A_XA, 1); SEAM(P_R1); }
    PHASE(P_GU1, B_GU(1, P_GU1));
    PHASE(P_DN1, B_DN(1, P_DN1));
    DBG_MOE(1)
    if (IN(P_C1)) { p_combine<false>(F, A, A_XA, A_out, 1); }
#if MK_CHECK
    { xcd_barrier(bar); const float e2 = __builtin_bit_cast(float, __hip_atomic_load((unsigned*)(F.ctl + CW_DBG), RLX_AGENT)), r2 = __builtin_bit_cast(float, __hip_atomic_load((unsigned*)(F.ctl + CW_DBG + 1), RLX_AGENT));
      const float dv = __builtin_fminf(MK_CHECK_GAIN * sqrtf(e2 / (r2 + 1e-30f)), 4.0f);
      for (size_t i = (size_t)blockIdx.x * 512 + ((int)threadIdx.x); i < (size_t)NTOK * D / 4; i += (size_t)F.G * 512) { f32x4 v = ((f32x4*)A_out)[i]; v = v + dv; ((f32x4*)A_out)[i] = v; } }
#endif
#if MK_LAST_PHASE < 99
    if (hi == P_COUNT) {
        if (!MK_PER_PHASE) xcd_barrier(bar);
        const float* src = (MK_LAST_PHASE < P_AOUT) ? A_x : (MK_LAST_PHASE < P_C0) ? A_XA : (MK_LAST_PHASE < P_BOUT) ? (const float*)nullptr : A_XA;
        if (src) for (size_t i = (size_t)blockIdx.x * 512 + ((int)threadIdx.x); i < (size_t)NTOK * D / 4; i += (size_t)F.G * 512) ((f32x4*)A_out)[i] = ((const f32x4*)src)[i];
    }
#endif
#undef IN
#undef SEAM
}

extern "C" void kernel_launch(void* const* d_in, const int* in_sizes, int n_in, void* d_out, int out_size, void* d_ws, size_t ws_size, hipStream_t stream) {
    static int grid = 0;
    if (grid == 0) {
        if (n_in != 22 || out_size != NTOK * D || ws_size < WS_END2) { fprintf(stderr, "kernel_launch: unexpected shapes (n_in %d, out %d, ws %zu < %zu)\n", n_in, out_size, ws_size, (size_t)WS_END); grid = -1; return; }
        int dev = 0, cus = 0, per_cu = 0;
        if (hipGetDevice(&dev) != hipSuccess || hipDeviceGetAttribute(&cus, hipDeviceAttributeMultiprocessorCount, dev) != hipSuccess) { grid = -1; return; }
        if (hipFuncSetAttribute((const void*)mk_fwd, hipFuncAttributeMaxDynamicSharedMemorySize, LDS_BYTES) != hipSuccess) { fprintf(stderr, "kernel_launch: hipFuncSetAttribute failed\n"); grid = -1; return; }
        if (hipOccupancyMaxActiveBlocksPerMultiprocessor(&per_cu, (const void*)mk_fwd, NWAVES * 64, LDS_BYTES) != hipSuccess || per_cu < 1) { fprintf(stderr, "kernel_launch: occupancy query says %d\n", per_cu); }
        (void)hipGetLastError();
        grid = cus;
    }
    if (grid < 0) return;
    if (hipMemsetAsync((char*)d_ws + WS_CTL, 0, CTL_ZERO_BYTES, stream) != hipSuccess) return;
    Args a{};
    for (int i = 0; i < 22; ++i) a.in[i] = d_in[i];
    a.out = (float*)d_out; a.ws = (unsigned char*)d_ws;
#if MK_PER_PHASE
    for (int p = 0; p < P_COUNT; ++p) { a.ph_lo = p; a.ph_hi = p + 1; hipLaunchKernelGGL(mk_fwd, dim3(grid), dim3(NWAVES * 64), LDS_BYTES, stream, a); }
#else
    a.ph_lo = 0; a.ph_hi = P_COUNT;
    hipLaunchKernelGGL(mk_fwd, dim3(grid), dim3(NWAVES * 64), LDS_BYTES, stream, a);
#endif
    const hipError_t le = hipPeekAtLastError();
    if (le != hipSuccess) fprintf(stderr, "kernel_launch: launch failed: %s\n", hipGetErrorName(le));
}
```
